# Optimizing an MI355X kernel written in HIP

```python
import math
import jax, jax.numpy as jnp
from jax import lax
import numpy as np

D_MODEL = 1024
BATCH = 4
SEQ = 8192
DEPTH = 2

CTX_LEN = 256
GRID_W = 64
N_EVEN = (DEPTH + 1) // 2
N_ODD = DEPTH // 2
NORM_EPS = 1e-6
ROPE_THETA = 10000.0
ROPE_DIM = 64
NEG_INF = -1e30

DA_HEADS = 4
DA_QK_DIM = 64
DA_V_DIM = 2 * DA_QK_DIM
DA_QK_W = DA_HEADS * 2 * DA_QK_DIM
WA_Q_HEADS = 8
WA_KV_HEADS = 2
WA_GROUP = WA_Q_HEADS // WA_KV_HEADS
WA_HEAD_DIM = 64
WINDOW = 128
BLOCK = 128

EVEN_WIDTHS = (DA_QK_W, DA_QK_W, DA_HEADS * DA_V_DIM, WA_Q_HEADS * WA_HEAD_DIM,
               WA_KV_HEADS * WA_HEAD_DIM, WA_KV_HEADS * WA_HEAD_DIM)
EVEN_IN = sum(EVEN_WIDTHS)
EVEN_SPLITS = tuple(int(v) for v in np.cumsum(EVEN_WIDTHS)[:-1])
EVEN_MIX = DA_HEADS * DA_V_DIM + WA_Q_HEADS * WA_HEAD_DIM

GLA_HEADS = 4
GLA_K_DIM = 64
GLA_V_DIM = 128
GLA_GATE_RANK = 16
GLA_GATE_NORM = 16.0
GLA_CHUNK = 64
LRU_WIDTH = 512
LRU_BLOCKS = 8
LRU_CONV = 4
CONV_LEFT = (LRU_CONV - 1) // 2
LRU_C = 8.0

ODD_WIDTHS = (GLA_HEADS * GLA_K_DIM, GLA_HEADS * GLA_K_DIM, GLA_HEADS * GLA_V_DIM,
              GLA_HEADS * GLA_V_DIM, 2 * GLA_GATE_RANK, LRU_WIDTH, LRU_WIDTH)
ODD_IN = sum(ODD_WIDTHS)
ODD_SPLITS = tuple(int(v) for v in np.cumsum(ODD_WIDTHS)[:-1])
ODD_MIX = GLA_HEADS * GLA_V_DIM + LRU_WIDTH

D_FF = ((8 * D_MODEL + 3 * 256 - 1) // (3 * 256)) * 256

kernel_name = 'hybrid_diffusion_trunk'


def rms_norm(x, g):
    xf = x.astype(jnp.float32)
    y = xf * lax.rsqrt(jnp.mean(xf * xf, axis=-1, keepdims=True) + NORM_EPS)
    return (y * g.astype(jnp.float32)).astype(x.dtype)


def head_rms(x):
    xf = x.astype(jnp.float32)
    return xf * lax.rsqrt(jnp.mean(xf * xf, axis=-1, keepdims=True) + NORM_EPS)


def modulate(h, shift, scale):
    return h * (1 + scale) + shift


def swiglu(h, w_in, w_out):
    gate, up = jnp.split(h @ w_in, 2, axis=-1)
    return (jax.nn.silu(gate) * up) @ w_out


def rope_tables(n_tokens):
    n_rows = n_tokens // GRID_W
    row = jnp.broadcast_to(jnp.arange(n_rows)[:, None], (n_rows, GRID_W)).reshape(-1)
    col = jnp.broadcast_to(jnp.arange(GRID_W)[None, :], (n_rows, GRID_W)).reshape(-1)
    axis_dim = ROPE_DIM // 2
    inv_freq = ROPE_THETA ** (-jnp.arange(0, axis_dim, 2, dtype=jnp.float32) / axis_dim)
    ang_r = row.astype(jnp.float32)[:, None] * inv_freq
    ang_c = col.astype(jnp.float32)[:, None] * inv_freq
    return (jnp.cos(ang_r), jnp.sin(ang_r), jnp.cos(ang_c), jnp.sin(ang_c))


def _rot_half(x, cos, sin):
    x1, x2 = jnp.split(x, 2, axis=-1)
    return jnp.concatenate([x1 * cos - x2 * sin, x1 * sin + x2 * cos], axis=-1)


def apply_axial_rope(x, tables):
    shape = (1, x.shape[1]) + (1,) * (x.ndim - 3) + (-1,)
    cos_r, sin_r, cos_c, sin_c = (t.reshape(shape) for t in tables)
    xf = x.astype(jnp.float32)
    half = x.shape[-1] // 2
    out = jnp.concatenate([_rot_half(xf[..., :half], cos_r, sin_r),
                           _rot_half(xf[..., half:], cos_c, sin_c)], axis=-1)
    return out.astype(x.dtype)


def diff_attn_core(q, k, v, lam):
    s = jnp.einsum('bqhmd,bkhmd->bhmqk', q, k).astype(jnp.float32) * (DA_QK_DIM ** -0.5)
    p = jax.nn.softmax(s, axis=-1)
    w = p[:, :, 0] - lam * p[:, :, 1]
    return jnp.einsum('bhqk,bkhd->bqhd', w.astype(v.dtype), v)


def diff_head_out(o, lam_init):
    y = head_rms(o) * (1.0 - lam_init)
    return y.reshape(o.shape[0], o.shape[1], -1).astype(o.dtype)


def gqa_scores(q, k):
    return jnp.einsum('bqhgd,bkhd->bhgqk', q, k).astype(jnp.float32) * (WA_HEAD_DIM ** -0.5)


def gqa_values(p, v):
    return jnp.einsum('bhgqk,bkhd->bqhgd', p.astype(v.dtype), v)


def sink_softmax(scores, sink):
    s_sink = jnp.broadcast_to(sink[None, :, :, None, None], scores[0].shape[:-1] + (1,))
    p = jax.nn.softmax(jnp.concatenate([s_sink] + scores, axis=-1), axis=-1)
    bounds = [1]
    for s in scores:
        bounds.append(bounds[-1] + s.shape[-1])
    return [p[..., bounds[i]:bounds[i + 1]] for i in range(len(scores))]


def window_gqa(q, k, v, kc, vc, sink):
    B, L = q.shape[0], q.shape[1]
    nb = L // BLOCK

    def band(t):
        tp = jnp.pad(t, ((0, 0), (BLOCK, BLOCK)) + ((0, 0),) * (t.ndim - 2))
        tp = tp.reshape((B, nb + 2, BLOCK) + t.shape[2:])
        win = jnp.concatenate([tp[:, :-2], tp[:, 1:-1], tp[:, 2:]], axis=2)
        return win.swapaxes(0, 1)

    q_blocks = q.reshape((B, nb, BLOCK) + q.shape[2:]).swapaxes(0, 1)
    offs_q = jnp.arange(BLOCK)
    offs_k = jnp.arange(3 * BLOCK) - BLOCK
    rel_ok = jnp.abs(offs_k[None, :] - offs_q[:, None]) <= WINDOW

    def one_block(args):
        qq, kk, vv, bi = args
        kpos = bi * BLOCK + offs_k
        valid = rel_ok & ((kpos >= 0) & (kpos < L))[None, :]
        s_win = jnp.where(valid, gqa_scores(qq, kk), NEG_INF)
        p_ctx, p_win = sink_softmax([gqa_scores(qq, kc), s_win], sink)
        return gqa_values(p_ctx, vc) + gqa_values(p_win, vv)

    out = lax.map(one_block, (q_blocks, band(k), band(v), jnp.arange(nb)))
    return out.swapaxes(0, 1).reshape(B, L, -1)


def ctx_gqa(qc, kc, vc, sink):
    (p,) = sink_softmax([gqa_scores(qc, kc)], sink)
    o = gqa_values(p, vc)
    return o.reshape(o.shape[0], o.shape[1], -1)


def _split_even(p):
    B, T = p.shape[0], p.shape[1]
    qa, ka, va, qb, kb, vb = jnp.split(p, EVEN_SPLITS, axis=-1)
    return (qa.reshape(B, T, DA_HEADS, 2, DA_QK_DIM), ka.reshape(B, T, DA_HEADS, 2, DA_QK_DIM),
            va.reshape(B, T, DA_HEADS, DA_V_DIM),
            qb.reshape(B, T, WA_KV_HEADS, WA_GROUP, WA_HEAD_DIM),
            kb.reshape(B, T, WA_KV_HEADS, WA_HEAD_DIM), vb.reshape(B, T, WA_KV_HEADS, WA_HEAD_DIM))


def even_mixer(hc, hl, w_in, w_out, lam_vec, sink, lam_init, rope, need_ctx):
    B, L = hl.shape[0], hl.shape[1]
    qa_c, ka_c, va_c, qb_c, kb_c, vb_c = _split_even(hc @ w_in)
    qa_l, ka_l, va_l, qb_l, kb_l, vb_l = _split_even(hl @ w_in)
    qa_l, ka_l, qb_l, kb_l = (apply_axial_rope(t, rope) for t in (qa_l, ka_l, qb_l, kb_l))
    lv = lam_vec.astype(jnp.float32)
    lam = jnp.exp(jnp.sum(lv[0] * lv[1])) - jnp.exp(jnp.sum(lv[2] * lv[3])) + lam_init
    sink_g = sink.astype(jnp.float32).reshape(WA_KV_HEADS, WA_GROUP)

    k_all = jnp.concatenate([ka_c, ka_l], axis=1)
    v_all = jnp.concatenate([va_c, va_l], axis=1)
    nb = L // BLOCK
    qa_blocks = qa_l.reshape((B, nb, BLOCK) + qa_l.shape[2:]).swapaxes(0, 1)
    a_l = lax.map(lambda qq: diff_attn_core(qq, k_all, v_all, lam), qa_blocks)
    a_l = diff_head_out(a_l.swapaxes(0, 1).reshape(B, L, DA_HEADS, DA_V_DIM), lam_init)
    b_l = window_gqa(qb_l, kb_l, vb_l, kb_c, vb_c, sink_g)
    y_l = jnp.concatenate([a_l, b_l], axis=-1) @ w_out
    y_c = None
    if need_ctx:
        a_c = diff_head_out(diff_attn_core(qa_c, ka_c, va_c, lam), lam_init)
        b_c = ctx_gqa(qb_c, kb_c, vb_c, sink_g)
        y_c = jnp.concatenate([a_c, b_c], axis=-1) @ w_out
    return y_c, y_l


def gla_chunked(q, k, v, log_a, S0):
    B, T, H = q.shape[0], q.shape[1], q.shape[2]
    C = GLA_CHUNK
    n = T // C

    def to_chunks(t):
        return t.reshape(B, n, C, H, t.shape[-1]).transpose(1, 0, 3, 2, 4)

    causal = jnp.tril(jnp.ones((C, C), dtype=bool))[:, :, None]

    def step(S, inp):
        qc, kc, vc, gc = inp
        b = jnp.cumsum(gc, axis=2)
        b_last = b[:, :, -1]
        o_inter = jnp.einsum('bhcd,bhde->bhce', qc * jnp.exp(b), S)
        diff = jnp.where(causal, b[:, :, :, None, :] - b[:, :, None, :, :], -jnp.inf)
        A = jnp.einsum('bhid,bhjd,bhijd->bhij', qc, kc, jnp.exp(diff))
        o = o_inter + jnp.einsum('bhij,bhje->bhie', A, vc)
        S_new = jnp.exp(b_last)[..., None] * S + jnp.einsum(
            'bhcd,bhce->bhde', kc * jnp.exp(b_last[:, :, None] - b), vc)
        return S_new, o

    S, o = lax.scan(step, S0, (to_chunks(q), to_chunks(k), to_chunks(v), to_chunks(log_a)))
    o = o.transpose(1, 0, 3, 2, 4).reshape(B, T, H, v.shape[-1])
    return o, S


def centred_conv(x, w, b):
    T = x.shape[1]
    xp = jnp.pad(x, ((0, 0), (CONV_LEFT, LRU_CONV - 1 - CONV_LEFT), (0, 0)))
    return sum(xp[:, j:j + T] * w[j] for j in range(LRU_CONV)) + b


def rglru_coeffs(x, wa, ba, wx, bx, lam):
    f32 = jnp.float32
    xb = x.reshape(x.shape[:-1] + (LRU_BLOCKS, LRU_WIDTH // LRU_BLOCKS))
    r = jax.nn.sigmoid(jnp.einsum('btnc,ncd->btnd', xb, wa.astype(f32)).reshape(x.shape) + ba.astype(f32))
    i = jax.nn.sigmoid(jnp.einsum('btnc,ncd->btnd', xb, wx.astype(f32)).reshape(x.shape) + bx.astype(f32))
    log_a = -LRU_C * r * jax.nn.softplus(-lam.astype(f32))
    a = jnp.exp(log_a)
    u = jnp.sqrt(-jnp.expm1(2.0 * log_a)) * (i * x)
    return a, u


def linear_scan(a, u, h0):
    u = u.at[:, 0].add(a[:, 0] * h0)

    def combine(lhs, rhs):
        return lhs[0] * rhs[0], rhs[0] * lhs[1] + rhs[1]

    _, h = lax.associative_scan(combine, (a, u), axis=1)
    return h


def odd_mixer(hc, hl, w_in, w_out, gate_w, gate_b, gla_g, conv_w, conv_b,
              wa, ba, wx, bx, lam, need_ctx):
    f32 = jnp.float32
    B = hl.shape[0]

    def project(h):
        T = h.shape[1]
        q, k, v, g, lr, zg, zx = jnp.split(h @ w_in, ODD_SPLITS, axis=-1)
        q = q.astype(f32).reshape(B, T, GLA_HEADS, GLA_K_DIM) * (GLA_K_DIM ** -0.5)
        k = k.astype(f32).reshape(B, T, GLA_HEADS, GLA_K_DIM)
        v = v.astype(f32).reshape(B, T, GLA_HEADS, GLA_V_DIM)
        lr = lr.astype(f32).reshape(B, T, 2, GLA_GATE_RANK)
        logit = jnp.einsum('btnr,nrk->btnk', lr, gate_w.astype(f32)) + gate_b.astype(f32)
        log_a = (jax.nn.log_sigmoid(logit) / GLA_GATE_NORM).reshape(B, T, 2, GLA_HEADS, GLA_K_DIM)
        xr = centred_conv(zx.astype(f32), conv_w.astype(f32), conv_b.astype(f32))
        return q, k, v, log_a, g, zg, xr

    qc, kc, vc, lac, gc, zgc, xrc = project(hc)
    ql, kl, vl, lal, gl, zgl, xrl = project(hl)
    S0 = jnp.zeros((B, GLA_HEADS, GLA_K_DIM, GLA_V_DIM), f32)
    h0 = jnp.zeros((B, LRU_WIDTH), f32)
    gla_c, gla_l, lru_c, lru_l = [], [], [], []
    for d in range(2):
        f = (lambda t: jnp.flip(t, axis=1)) if d == 1 else (lambda t: t)
        oc, S_ctx = gla_chunked(f(qc), f(kc), f(vc), f(lac[:, :, d]), S0)
        ol, _ = gla_chunked(f(ql), f(kl), f(vl), f(lal[:, :, d]), S_ctx)
        ac, uc = rglru_coeffs(f(xrc), wa[d], ba[d], wx[d], bx[d], lam[d])
        hcd = linear_scan(ac, uc, h0)
        al, ul = rglru_coeffs(f(xrl), wa[d], ba[d], wx[d], bx[d], lam[d])
        hld = linear_scan(al, ul, hcd[:, -1])
        gla_c.append(f(oc)); gla_l.append(f(ol)); lru_c.append(f(hcd)); lru_l.append(f(hld))

    def assemble(o_gla, g, h_lru, zg, dtype):
        T = o_gla.shape[1]
        y_gla = rms_norm(o_gla, gla_g).reshape(B, T, -1) * jax.nn.silu(g.astype(f32))
        y_lru = h_lru * jax.nn.gelu(zg.astype(f32))
        return jnp.concatenate([y_gla, y_lru], axis=-1).astype(dtype) @ w_out

    y_l = assemble(gla_l[0] + gla_l[1], gl, lru_l[0] + lru_l[1], zgl, hl.dtype)
    y_c = None
    if need_ctx:
        y_c = assemble(gla_c[0] + gla_c[1], gc, lru_c[0] + lru_c[1], zgc, hc.dtype)
    return y_c, y_l


def setup_inputs(seed: int = 0) -> dict:
    key = jax.random.key(seed)
    ks = iter(jax.random.split(key, 40))
    f32 = jnp.float32

    def nrm(shape, scale):
        return jax.random.normal(next(ks), shape, f32) * scale

    blk = LRU_WIDTH // LRU_BLOCKS
    x = nrm((BATCH, SEQ, D_MODEL), 1.0)
    c = nrm((BATCH, D_MODEL), 1.0)
    ctx = nrm((BATCH, CTX_LEN, D_MODEL), 1.0)
    c_ctx = nrm((D_MODEL,), 1.0)
    ada_w = nrm((DEPTH, D_MODEL, 6 * D_MODEL), 0.5 * D_MODEL ** -0.5)
    ada_b = nrm((DEPTH, 6 * D_MODEL), 0.02)
    norm_g = 1.0 + nrm((DEPTH, 2, D_MODEL), 0.02)
    even_w_in = nrm((N_EVEN, D_MODEL, EVEN_IN), D_MODEL ** -0.5)
    even_w_out = nrm((N_EVEN, EVEN_MIX, D_MODEL), EVEN_MIX ** -0.5)
    diff_lam = nrm((N_EVEN, 4, DA_QK_DIM), 0.1)
    win_sink = nrm((N_EVEN, WA_Q_HEADS), 0.5)
    odd_w_in = nrm((N_ODD, D_MODEL, ODD_IN), D_MODEL ** -0.5)
    odd_w_out = nrm((N_ODD, ODD_MIX, D_MODEL), ODD_MIX ** -0.5)
    gla_gate_w = nrm((N_ODD, 2, GLA_GATE_RANK, GLA_HEADS * GLA_K_DIM), GLA_GATE_RANK ** -0.5)
    gla_gate_b = nrm((N_ODD, 2, GLA_HEADS * GLA_K_DIM), 0.1)
    gla_norm_g = 1.0 + nrm((N_ODD, GLA_V_DIM), 0.02)
    lru_conv_w = nrm((N_ODD, LRU_CONV, LRU_WIDTH), LRU_CONV ** -0.5)
    lru_conv_b = nrm((N_ODD, LRU_WIDTH), 0.02)
    lru_wa = nrm((N_ODD, 2, LRU_BLOCKS, blk, blk), blk ** -0.5)
    lru_ba = nrm((N_ODD, 2, LRU_WIDTH), 0.02)
    lru_wx = nrm((N_ODD, 2, LRU_BLOCKS, blk, blk), blk ** -0.5)
    lru_bx = nrm((N_ODD, 2, LRU_WIDTH), 0.02)
    u = jax.random.uniform(next(ks), (N_ODD, 2, LRU_WIDTH), f32, 0.9, 0.999)
    s = u ** (1.0 / LRU_C)
    lru_lam = jnp.log(s) - jnp.log1p(-s)
    ffn_w_in = nrm((DEPTH, D_MODEL, 2 * D_FF), D_MODEL ** -0.5)
    ffn_w_out = nrm((DEPTH, D_FF, D_MODEL), D_FF ** -0.5)
    final_g = 1.0 + nrm((D_MODEL,), 0.02)
    return {'x': x, 'c': c, 'ctx': ctx, 'c_ctx': c_ctx, 'ada_w': ada_w, 'ada_b': ada_b,
            'norm_g': norm_g, 'even_w_in': even_w_in, 'even_w_out': even_w_out,
            'diff_lam': diff_lam, 'win_sink': win_sink, 'odd_w_in': odd_w_in,
            'odd_w_out': odd_w_out, 'gla_gate_w': gla_gate_w, 'gla_gate_b': gla_gate_b,
            'gla_norm_g': gla_norm_g, 'lru_conv_w': lru_conv_w, 'lru_conv_b': lru_conv_b,
            'lru_wa': lru_wa, 'lru_ba': lru_ba, 'lru_wx': lru_wx, 'lru_bx': lru_bx,
            'lru_lam': lru_lam, 'ffn_w_in': ffn_w_in, 'ffn_w_out': ffn_w_out, 'final_g': final_g}


def reference(x, c, ctx, c_ctx, ada_w, ada_b, norm_g, even_w_in, even_w_out, diff_lam, win_sink,
              odd_w_in, odd_w_out, gla_gate_w, gla_gate_b, gla_norm_g, lru_conv_w, lru_conv_b,
              lru_wa, lru_ba, lru_wx, lru_bx, lru_lam, ffn_w_in, ffn_w_out, final_g):
    rope = rope_tables(x.shape[1])
    xl, xc = x, ctx
    cond_l = jax.nn.silu(c)[:, None, :]
    cond_c = jax.nn.silu(c_ctx)
    for li in range(DEPTH):
        last = li == DEPTH - 1
        sh1, sc1, g1, sh2, sc2, g2 = jnp.split(cond_l @ ada_w[li] + ada_b[li], 6, axis=-1)
        csh1, csc1, cg1, csh2, csc2, cg2 = jnp.split(cond_c @ ada_w[li] + ada_b[li], 6, axis=-1)
        hl = modulate(rms_norm(xl, norm_g[li, 0]), sh1, sc1)
        hc = modulate(rms_norm(xc, norm_g[li, 0]), csh1, csc1)
        if li % 2 == 0:
            e = li // 2
            lam_init = 0.8 - 0.6 * math.exp(-0.3 * li)
            yc, yl = even_mixer(hc, hl, even_w_in[e], even_w_out[e], diff_lam[e], win_sink[e],
                                lam_init, rope, not last)
        else:
            o = li // 2
            yc, yl = odd_mixer(hc, hl, odd_w_in[o], odd_w_out[o], gla_gate_w[o], gla_gate_b[o],
                               gla_norm_g[o], lru_conv_w[o], lru_conv_b[o], lru_wa[o], lru_ba[o],
                               lru_wx[o], lru_bx[o], lru_lam[o], not last)
        xl = xl + g1 * yl
        xl = xl + g2 * swiglu(modulate(rms_norm(xl, norm_g[li, 1]), sh2, sc2), ffn_w_in[li], ffn_w_out[li])
        if not last:
            xc = xc + cg1 * yc
            xc = xc + cg2 * swiglu(modulate(rms_norm(xc, norm_g[li, 1]), csh2, csc2),
                                   ffn_w_in[li], ffn_w_out[li])
    return rms_norm(xl, final_g)
```

```cpp
#include <hip/hip_runtime.h>
#include <hip/hip_cooperative_groups.h>
#include <cstdio>
namespace cg = cooperative_groups;

#define DI __device__ __forceinline__
#define LAS __attribute__((address_space(3)))
typedef unsigned short bf16_t;
typedef short bf16x8 __attribute__((ext_vector_type(8)));
typedef short s16x4 __attribute__((ext_vector_type(4)));
typedef float f32x2 __attribute__((ext_vector_type(2)));
typedef float f32x4 __attribute__((ext_vector_type(4)));
typedef float f32x16 __attribute__((ext_vector_type(16)));
typedef unsigned u32x2 __attribute__((ext_vector_type(2)));
typedef unsigned u32x4 __attribute__((ext_vector_type(4)));
typedef __bf16 bf16x2_t __attribute__((ext_vector_type(2)));

constexpr int NB = 4, LQ = 8192, LC = 256, DM = 1024;
constexpr int ML = NB * LQ, MC = NB * LC, MT = ML + MC;
constexpr int EIN = 2304, OINP = 2816, DFF = 2816;
constexpr int NCH = 132;
constexpr int NTHR = 512;
constexpr int LDS_BYTES = 147456;
constexpr float LOG2E = 1.4426950408889634f;

constexpr size_t al256(size_t x) { return (x + 255) & ~(size_t)255; }
constexpr size_t WS_H = 0;
constexpr size_t WS_P = al256(WS_H + (size_t)MT * DM * 2);
constexpr size_t WS_MIX = al256(WS_P + (size_t)MT * 2816 * 2);
constexpr size_t WS_XC = al256(WS_MIX + (size_t)MT * DM * 2);
constexpr size_t WS_W_EIN = al256(WS_XC + (size_t)MC * DM * 4);
constexpr size_t WS_W_EOUT = al256(WS_W_EIN + (size_t)EIN * DM * 2);
constexpr size_t WS_W_OIN = al256(WS_W_EOUT + (size_t)DM * DM * 2);
constexpr size_t WS_W_OOUT = al256(WS_W_OIN + (size_t)OINP * DM * 2);
constexpr size_t WS_W_FIN = al256(WS_W_OOUT + (size_t)DM * DM * 2);
constexpr size_t WS_W_FOUT = al256(WS_W_FIN + (size_t)2 * 5632 * DM * 2);
constexpr size_t WS_MOD = al256(WS_W_FOUT + (size_t)2 * DM * DFF * 2);
constexpr size_t WS_ROPE = al256(WS_MOD + (size_t)2 * 5 * 6144 * 4);
constexpr size_t WS_WGT = al256(WS_ROPE + (size_t)128 * 16 * 2 * 4);
constexpr size_t WS_SCAL = al256(WS_WGT + (size_t)2 * 2 * 8 * 64 * 64 * 2);
constexpr size_t WS_GDEC = al256(WS_SCAL + 256);
constexpr size_t WS_LRUP = al256(WS_GDEC + (size_t)32 * NCH * 64 * 4);
constexpr size_t WS_LRUC = al256(WS_LRUP + (size_t)8 * NCH * 512 * 2 * 4);
constexpr size_t WS_SMALL = al256(WS_LRUC + (size_t)8 * NCH * 512 * 4);
constexpr int SM_NORMG = 0, SM_SINK = 4096, SM_GGW = 4160, SM_GGB = 12352, SM_GNG = 12864, SM_CW = 12992, SM_CB = 15040, SM_BA = 15552, SM_BX = 16576, SM_LAM = 17600, SM_FG = 18624, SM_TOTAL = 19648;
constexpr size_t WS_QT = al256(WS_SMALL + (size_t)SM_TOTAL * 4);
constexpr size_t WS_KT = al256(WS_QT + (size_t)MT * 512 * 2);
constexpr size_t WS_X = al256(WS_KT + (size_t)MT * 512 * 2);
constexpr size_t WS_BAR = al256(WS_X + (size_t)MT * DM * 2);
constexpr size_t WS_PTRS = al256(WS_BAR + 3456 * 4);
constexpr size_t WS_END = al256(WS_PTRS + 256);

struct Params { const float* in[26]; float* out; unsigned char* ws; };

DI unsigned pk2(float lo, float hi) { f32x2 v = {lo, hi}; return __builtin_bit_cast(unsigned, __builtin_convertvector(v, bf16x2_t)); }
DI bf16_t f2bf(float x) { return (bf16_t)(pk2(x, 0.f) & 0xffffu); }
DI float bflo(unsigned u) { return __uint_as_float(u << 16); }
DI float bfhi(unsigned u) { return __uint_as_float(u & 0xffff0000u); }
DI float bf2f(bf16_t h) { return __uint_as_float((unsigned)h << 16); }
DI int otid_(int wv) { unsigned z = 0u; asm volatile("" : "+v"(z)); return (wv << 6) | (int)__builtin_amdgcn_mbcnt_hi(~0u, __builtin_amdgcn_mbcnt_lo(~0u, z)); }
#define otid() otid_(wv_)
DI float shx(float v, int mask, int lane) { return __int_as_float(__builtin_amdgcn_ds_bpermute((lane ^ mask) << 2, __float_as_int(v))); }
DI int crow(int reg, int h) { return (reg & 3) + 8 * (reg >> 2) + 4 * h; }
DI float sigmoidf_(float x) { return __builtin_amdgcn_rcpf(1.0f + __expf(-x)); }
DI float siluf_(float x) { return x * __builtin_amdgcn_rcpf(1.0f + __expf(-x)); }
DI float gelu_tanh(float x) { const float u = 0.7978845608028654f * (x + 0.044715f * x * x * x); const float t = 1.0f - 2.0f * __builtin_amdgcn_rcpf(1.0f + __expf(2.0f * u)); return 0.5f * x * (1.0f + t); }
DI float log1p_small(float e) { return e < 0.01f ? e * (1.0f - e * (0.5f - e * 0.33333333f)) : __logf(1.0f + e); }
DI float log_sigmoidf_(float x) { return fminf(x, 0.f) - log1p_small(__expf(-fabsf(x))); }
DI float neg_expm1(float x) { return x > -0.01f ? -x * (1.0f + x * (0.5f + x * 0.16666667f)) : 1.0f - __expf(x); }
#define MFMA32(a, b, c) __builtin_amdgcn_mfma_f32_32x32x16_bf16((a), (b), (c), 0, 0, 0)
DI f32x16 zero16() { f32x16 z; for (int i = 0; i < 16; ++i) z[i] = 0.f; return z; }
DI bf16x8 pack8(const f32x16& x, int s) {
    u32x4 p; p[0] = pk2(x[8 * s], x[8 * s + 1]); p[1] = pk2(x[8 * s + 2], x[8 * s + 3]); p[2] = pk2(x[8 * s + 4], x[8 * s + 5]); p[3] = pk2(x[8 * s + 6], x[8 * s + 7]);
    return __builtin_bit_cast(bf16x8, p);
}
DI bf16x8 tr_frag(LAS unsigned char* img, int pitch, int ka, int kb, int col0, int lane) {
    const int q_ = (lane & 15) >> 2, p_ = lane & 3;
    const s16x4 lo = __builtin_amdgcn_ds_read_tr16_b64_v4i16((LAS s16x4*)(img + (ka + q_) * pitch + (col0 + 4 * p_) * 2));
    const s16x4 hi = __builtin_amdgcn_ds_read_tr16_b64_v4i16((LAS s16x4*)(img + (kb + q_) * pitch + (col0 + 4 * p_) * 2));
    return __builtin_shufflevector(lo, hi, 0, 1, 2, 3, 4, 5, 6, 7);
}
DI int chunk_row0(int b, int cid) { return cid < 4 ? ML + b * LC + cid * 64 : b * LQ + (cid - 4) * 64; }

DI void tr_tile(LAS unsigned char* lds, const float* __restrict__ src, int ldsrc, int scol0, bool valid, int k0, bf16_t* __restrict__ dst, int lddst, int n0, int wv_) {
    LAS bf16_t* T = (LAS bf16_t*)lds;
    const int tid = otid(), nn = tid & 63, kq = tid >> 6;
#pragma unroll
    for (int it = 0; it < 8; ++it) { const int kk = kq + 8 * it; const float v = valid ? src[(size_t)(k0 + kk) * ldsrc + scol0 + nn] : 0.f; T[nn * 72 + kk] = f2bf(v); }
    __syncthreads();
    const int n = tid >> 3, ks = (tid & 7) * 8;
    const u32x4 w = *(LAS u32x4*)(T + n * 72 + ks);
    *(u32x4*)(dst + (size_t)(n0 + n) * lddst + k0 + ks) = w;
    __syncthreads();
}
DI void tr_tile4(LAS unsigned char* lds, const float* __restrict__ src, int ldsrc, int scol0, bool valid, int k0, bf16_t* __restrict__ dst, int lddst, int n0, int wv_) {
    LAS bf16_t* T = (LAS bf16_t*)lds;
    const int tid = otid(), nn = tid & 63, kq = tid >> 6;
    float v[32];
#pragma unroll
    for (int it = 0; it < 32; ++it) v[it] = valid ? src[(size_t)(k0 + kq + 8 * it) * ldsrc + scol0 + nn] : 0.f;
#pragma unroll
    for (int it = 0; it < 32; ++it) T[nn * 264 + kq + 8 * it] = f2bf(v[it]);
    __syncthreads();
    const int n = tid >> 3, ks = (tid & 7) * 32;
#pragma unroll
    for (int j = 0; j < 4; ++j) { const u32x4 w = *(LAS u32x4*)(T + n * 264 + ks + 8 * j); *(u32x4*)(dst + (size_t)(n0 + n) * lddst + k0 + ks + 8 * j) = w; }
    __syncthreads();
}
DI void tr_item(LAS unsigned char* lds, int item, const float* src, int K, int Nsrc, bf16_t* dst, int mode, int wv_) {
    const int nkt = K / 256; const int nt = item / nkt, kt = item % nkt; const int n0 = nt * 64;
    int scol0 = n0; bool valid = n0 < Nsrc;
    if (mode == 1) { scol0 = ((n0 & 255) >> 7) * DFF + 128 * (n0 >> 8) + (n0 & 127); valid = true; }
    tr_tile4(lds, src, Nsrc, scol0, valid, kt * 256, dst, K, n0, wv_);
}
DI void adaln_item(LAS unsigned char* lds, const float* __restrict__ cin, const float* __restrict__ cctx, const float* __restrict__ adaw, const float* __restrict__ adab, unsigned char* ws, int li, int cgp, int wv_) {
    LAS float* SC = (LAS float*)lds;
    LAS float* RED = SC + 5120;
    const int tid = otid();
    for (int idx = tid; idx < 5120; idx += NTHR) { const int s = idx >> 10, k = idx & 1023; const float c = s < 4 ? cin[s * 1024 + k] : cctx[k]; SC[idx] = siluf_(c); }
    __syncthreads();
    const int col = cgp * 64 + (tid & 63), kg = tid >> 6;
    float a0 = 0.f, a1 = 0.f, a2 = 0.f, a3 = 0.f, a4 = 0.f;
    const float* w = adaw + ((size_t)li * 1024 + kg * 128) * 6144 + col;
#pragma unroll 8
    for (int kk = 0; kk < 128; ++kk) { const float wv = w[(size_t)kk * 6144]; const int k = kg * 128 + kk;
        a0 += SC[k] * wv; a1 += SC[1024 + k] * wv; a2 += SC[2048 + k] * wv; a3 += SC[3072 + k] * wv; a4 += SC[4096 + k] * wv; }
    RED[(kg * 5 + 0) * 64 + (tid & 63)] = a0; RED[(kg * 5 + 1) * 64 + (tid & 63)] = a1; RED[(kg * 5 + 2) * 64 + (tid & 63)] = a2;
    RED[(kg * 5 + 3) * 64 + (tid & 63)] = a3; RED[(kg * 5 + 4) * 64 + (tid & 63)] = a4;
    __syncthreads();
    if (tid < 320) { const int s = tid >> 6, c = tid & 63; float acc = 0.f;
#pragma unroll
        for (int g = 0; g < 8; ++g) acc += RED[(g * 5 + s) * 64 + c];
        float* MOD = (float*)(ws + WS_MOD);
        MOD[(size_t)(li * 5 + s) * 6144 + cgp * 64 + c] = acc + adab[li * 6144 + cgp * 64 + c]; }
    __syncthreads();
}
DI void tables_item(const Params& p, int wv_) {
    const int tid = otid();
    float* tab = (float*)(p.ws + WS_ROPE);
    for (int idx = tid; idx < 2048; idx += NTHR) {
        const int pos = idx >> 4, i = idx & 15;
        const double b4 = (i & 3) == 0 ? 1.0 : ((i & 3) == 1 ? 0.5623413251903491 : ((i & 3) == 2 ? 0.31622776601683794 : 0.1778279410038923));
        const double p10 = (i >> 2) == 0 ? 1.0 : ((i >> 2) == 1 ? 0.1 : ((i >> 2) == 2 ? 0.01 : 0.001));
        const float inv = (float)(b4 * p10);
        const float angf = (float)pos * inv;
        const double ang = (double)angf;
        const double kd = __builtin_rint(ang * 0.6366197723675814);
        const double r = ang - kd * 1.5707963267948966, r2 = r * r;
        const double sr = r * (1.0 - r2 / 6.0 * (1.0 - r2 / 20.0 * (1.0 - r2 / 42.0 * (1.0 - r2 / 72.0 * (1.0 - r2 / 110.0 * (1.0 - r2 / 156.0))))));
        const double cr = 1.0 - r2 / 2.0 * (1.0 - r2 / 12.0 * (1.0 - r2 / 30.0 * (1.0 - r2 / 56.0 * (1.0 - r2 / 90.0 * (1.0 - r2 / 132.0)))));
        const int kq = ((int)kd) & 3;
        const double cs = kq == 0 ? cr : (kq == 1 ? -sr : (kq == 2 ? -cr : sr));
        const double sn = kq == 0 ? sr : (kq == 1 ? cr : (kq == 2 ? -sr : -cr));
        tab[idx * 2] = (float)cs; tab[idx * 2 + 1] = (float)sn;
    }
    { float* SM = (float*)(p.ws + WS_SMALL);
      for (int i = tid; i < 4096; i += NTHR) SM[SM_NORMG + i] = p.in[6][i];
      for (int i = tid; i < 8; i += NTHR) SM[SM_SINK + i] = p.in[10][i];
      for (int i = tid; i < 8192; i += NTHR) SM[SM_GGW + i] = p.in[13][i];
      for (int i = tid; i < 512; i += NTHR) SM[SM_GGB + i] = p.in[14][i];
      for (int i = tid; i < 128; i += NTHR) SM[SM_GNG + i] = p.in[15][i];
      for (int i = tid; i < 2048; i += NTHR) SM[SM_CW + i] = p.in[16][i];
      for (int i = tid; i < 512; i += NTHR) SM[SM_CB + i] = p.in[17][i];
      for (int i = tid; i < 1024; i += NTHR) SM[SM_BA + i] = p.in[19][i];
      for (int i = tid; i < 1024; i += NTHR) SM[SM_BX + i] = p.in[21][i];
      for (int i = tid; i < 1024; i += NTHR) SM[SM_LAM + i] = p.in[22][i];
      for (int i = tid; i < 1024; i += NTHR) SM[SM_FG + i] = p.in[25][i]; }
    if (tid == 0) { const float** tab = (const float**)(p.ws + WS_PTRS);
#pragma unroll
        for (int i = 0; i < 26; ++i) tab[i] = p.in[i]; }
    if (tid == 0) { const float* lv = p.in[9]; float s1 = 0.f, s2 = 0.f;
        for (int i = 0; i < 64; ++i) { s1 += lv[i] * lv[64 + i]; s2 += lv[128 + i] * lv[192 + i]; }
        ((float*)(p.ws + WS_SCAL))[0] = expf(s1) - expf(s2) + 0.2f; }
}
constexpr int PC0 = 144, PC1 = PC0 + 64, PC2 = PC1 + 176, PC3 = PC2 + 64, PC4 = PC3 + 352, PC5 = PC4 + 352, PC6 = PC5 + 176, PC7 = PC6 + 176, PC8 = PC7 + 32, PC9 = PC8 + 192, PC10 = PC9 + 1;
#define PREP_ONE_BODY(IN, WS) \
    if (it < PC0) tr_item(lds, it, IN(7), 1024, EIN, (bf16_t*)((WS) + WS_W_EIN), 0, wv_); \
    else if (it < PC1) tr_item(lds, it - PC0, IN(8), 1024, 1024, (bf16_t*)((WS) + WS_W_EOUT), 0, wv_); \
    else if (it < PC2) tr_item(lds, it - PC1, IN(11), 1024, 2592, (bf16_t*)((WS) + WS_W_OIN), 0, wv_); \
    else if (it < PC3) tr_item(lds, it - PC2, IN(12), 1024, 1024, (bf16_t*)((WS) + WS_W_OOUT), 0, wv_); \
    else if (it < PC4) tr_item(lds, it - PC3, IN(23), 1024, 5632, (bf16_t*)((WS) + WS_W_FIN), 1, wv_); \
    else if (it < PC5) tr_item(lds, it - PC4, IN(23) + (size_t)1024 * 5632, 1024, 5632, (bf16_t*)((WS) + WS_W_FIN) + (size_t)5632 * 1024, 1, wv_); \
    else if (it < PC6) tr_item(lds, it - PC5, IN(24), DFF, 1024, (bf16_t*)((WS) + WS_W_FOUT), 0, wv_); \
    else if (it < PC7) tr_item(lds, it - PC6, IN(24) + (size_t)DFF * 1024, DFF, 1024, (bf16_t*)((WS) + WS_W_FOUT) + (size_t)1024 * DFF, 0, wv_); \
    else if (it < PC8) { const int j = it - PC7; const int dir = j >> 4, gate = (j >> 3) & 1, n = j & 7; \
        const float* src = (gate ? IN(20) : IN(18)) + (size_t)(dir * 8 + n) * 4096; \
        tr_tile(lds, src, 64, 0, true, 0, (bf16_t*)((WS) + WS_WGT) + (size_t)((dir * 2 + gate) * 8 + n) * 4096, 64, 0, wv_); } \
    else if (it < PC9) { const int j = it - PC8; adaln_item(lds, IN(1), IN(3), IN(4), IN(5), (WS), j / 96, j % 96, wv_); }
DI void prep_one(LAS unsigned char* lds, const Params& p, int it, int wv_) {
#define PIN_(i) p.in[i]
    PREP_ONE_BODY(PIN_, p.ws)
    else tables_item(p, wv_);
#undef PIN_
}
DI void prep_one_tab(LAS unsigned char* lds, unsigned char* ws, int it, int wv_) {
    const float* const* tab = (const float* const*)(ws + WS_PTRS);
#define PIN_(i) tab[i]
    PREP_ONE_BODY(PIN_, ws)
#undef PIN_
}
DI void phase0(LAS unsigned char* lds, const Params& p, int G, int bid, int wv_) {
    for (int k = bid; k < 241; k += G) prep_one(lds, p, k < 144 ? k : (k < 240 ? PC8 + (k - 144) : PC9), wv_);
}
DI void prep_slack(LAS unsigned char* lds, unsigned char* ws, int which, int idle_rank, int n_idle, int wv_) {
    const int n = which == 1 ? 64 : (which == 3 ? 528 : 896);
    for (int k = idle_rank; k < n; k += n_idle) {
        int it;
        if (which == 1) it = PC0 + k;
        else if (which == 3) it = k < 352 ? PC3 + k : PC5 + (k - 352);
        else it = k < 240 ? PC1 + k : (k < 592 ? PC4 + (k - 240) : (k < 800 ? PC6 + (k - 592) : PC8 + 96 + (k - 800)));
        prep_one_tab(lds, ws, it, wv_);
    }
}

DI float wave_sum(float v, int lane) {
#pragma unroll
    for (int off = 32; off >= 1; off >>= 1) v += shx(v, off, lane);
    return v;
}
DI void norm_phase(int G, int bid, int nrows, const float* __restrict__ xl, const float* __restrict__ xc, bf16_t* __restrict__ X, const float* __restrict__ g,
                   const float* __restrict__ mod, int sh_off, int sc_off, bf16_t* __restrict__ H, int wv_) {
    const int tid_ = otid(), lane = tid_ & 63, wave = __builtin_amdgcn_readfirstlane(tid_ >> 6);
    const int stride = G * 8;
    for (int r0 = bid * 8 + wave; r0 < nrows; r0 += 2 * stride) {
        const int r1 = r0 + stride; const bool has1 = r1 < nrows; const int r1c = has1 ? r1 : r0;
        const float* s0 = r0 < ML ? xl + (size_t)r0 * DM : xc + (size_t)(r0 - ML) * DM;
        const float* s1 = r1c < ML ? xl + (size_t)r1c * DM : xc + (size_t)(r1c - ML) * DM;
        f32x4 v0[4], v1[4]; float ss0 = 0.f, ss1 = 0.f;
#pragma unroll
        for (int j = 0; j < 4; ++j) { v0[j] = *(const f32x4*)(s0 + j * 256 + lane * 4); v1[j] = *(const f32x4*)(s1 + j * 256 + lane * 4); }
#pragma unroll
        for (int j = 0; j < 4; ++j) { ss0 += v0[j][0] * v0[j][0] + v0[j][1] * v0[j][1] + v0[j][2] * v0[j][2] + v0[j][3] * v0[j][3];
                                      ss1 += v1[j][0] * v1[j][0] + v1[j][1] * v1[j][1] + v1[j][2] * v1[j][2] + v1[j][3] * v1[j][3]; }
#pragma unroll
        for (int off = 32; off >= 1; off >>= 1) { ss0 += shx(ss0, off, lane); ss1 += shx(ss1, off, lane); }
        const float rstd0 = rsqrtf(ss0 * (1.0f / 1024.0f) + 1e-6f), rstd1 = rsqrtf(ss1 * (1.0f / 1024.0f) + 1e-6f);
        const float* m0 = mod + (size_t)(r0 < ML ? (r0 >> 13) : 4) * 6144; const float* m1 = mod + (size_t)(r1c < ML ? (r1c >> 13) : 4) * 6144;
#pragma unroll
        for (int j = 0; j < 4; ++j) { const int col = j * 256 + lane * 4; const f32x4 gg = *(const f32x4*)(g + col);
            const f32x4 h0 = v0[j] * rstd0 * gg * (*(const f32x4*)(m0 + sc_off + col) + 1.0f) + *(const f32x4*)(m0 + sh_off + col);
            const f32x4 h1 = v1[j] * rstd1 * gg * (*(const f32x4*)(m1 + sc_off + col) + 1.0f) + *(const f32x4*)(m1 + sh_off + col);
            u32x2 w0, w1, x0, x1; w0[0] = pk2(h0[0], h0[1]); w0[1] = pk2(h0[2], h0[3]); w1[0] = pk2(h1[0], h1[1]); w1[1] = pk2(h1[2], h1[3]);
            x0[0] = pk2(v0[j][0], v0[j][1]); x0[1] = pk2(v0[j][2], v0[j][3]); x1[0] = pk2(v1[j][0], v1[j][1]); x1[1] = pk2(v1[j][2], v1[j][3]);
            *(u32x2*)(H + (size_t)r0 * DM + col) = w0; *(u32x2*)(X + (size_t)r0 * DM + col) = x0;
            if (has1) { *(u32x2*)(H + (size_t)r1 * DM + col) = w1; *(u32x2*)(X + (size_t)r1 * DM + col) = x1; } }
    }
}
DI void unpack16(const u32x4& a, const u32x4& b, float (&f)[16]) {
#pragma unroll
    for (int j = 0; j < 4; ++j) { f[2 * j] = bflo(a[j]); f[2 * j + 1] = bfhi(a[j]); f[8 + 2 * j] = bflo(b[j]); f[8 + 2 * j + 1] = bfhi(b[j]); }
}
template <int MODE>
DI void norm_phase_x(int G, int bid, int nrows, const bf16_t* __restrict__ X, const float* __restrict__ g, const float* __restrict__ mod, int sh_off, int sc_off, bf16_t* __restrict__ H, float* __restrict__ out, int wv_) {
    const int tid_ = otid(), lane = tid_ & 63, wave = __builtin_amdgcn_readfirstlane(tid_ >> 6);
    const int stride = G * 8, col = lane * 16;
    for (int r0 = bid * 8 + wave; r0 < nrows; r0 += 2 * stride) {
        const int r1 = r0 + stride; const bool has1 = r1 < nrows; const int r1c = has1 ? r1 : r0;
        const u32x4 a0 = *(const u32x4*)(X + (size_t)r0 * DM + col), b0 = *(const u32x4*)(X + (size_t)r0 * DM + col + 8);
        const u32x4 a1 = *(const u32x4*)(X + (size_t)r1c * DM + col), b1 = *(const u32x4*)(X + (size_t)r1c * DM + col + 8);
        float v0[16], v1[16]; unpack16(a0, b0, v0); unpack16(a1, b1, v1);
        float ss0 = 0.f, ss1 = 0.f;
#pragma unroll
        for (int j = 0; j < 16; ++j) { ss0 += v0[j] * v0[j]; ss1 += v1[j] * v1[j]; }
#pragma unroll
        for (int off = 32; off >= 1; off >>= 1) { ss0 += shx(ss0, off, lane); ss1 += shx(ss1, off, lane); }
        const float rstd0 = rsqrtf(ss0 * (1.0f / 1024.0f) + 1e-6f), rstd1 = rsqrtf(ss1 * (1.0f / 1024.0f) + 1e-6f);
        if (MODE == 0) {
            const float* m0 = mod + (size_t)(r0 < ML ? (r0 >> 13) : 4) * 6144; const float* m1 = mod + (size_t)(r1c < ML ? (r1c >> 13) : 4) * 6144;
            u32x4 w0[2], w1[2];
#pragma unroll
            for (int q = 0; q < 4; ++q) { const f32x4 gg = *(const f32x4*)(g + col + 4 * q);
                const f32x4 sc0 = *(const f32x4*)(m0 + sc_off + col + 4 * q), sh0 = *(const f32x4*)(m0 + sh_off + col + 4 * q), sc1 = *(const f32x4*)(m1 + sc_off + col + 4 * q), sh1 = *(const f32x4*)(m1 + sh_off + col + 4 * q);
                const f32x4 x0 = {v0[4 * q], v0[4 * q + 1], v0[4 * q + 2], v0[4 * q + 3]}, x1 = {v1[4 * q], v1[4 * q + 1], v1[4 * q + 2], v1[4 * q + 3]};
                const f32x4 h0 = x0 * rstd0 * gg * (sc0 + 1.0f) + sh0, h1 = x1 * rstd1 * gg * (sc1 + 1.0f) + sh1;
                w0[q >> 1][(q & 1) * 2] = pk2(h0[0], h0[1]); w0[q >> 1][(q & 1) * 2 + 1] = pk2(h0[2], h0[3]); w1[q >> 1][(q & 1) * 2] = pk2(h1[0], h1[1]); w1[q >> 1][(q & 1) * 2 + 1] = pk2(h1[2], h1[3]); }
            *(u32x4*)(H + (size_t)r0 * DM + col) = w0[0]; *(u32x4*)(H + (size_t)r0 * DM + col + 8) = w0[1];
            if (has1) { *(u32x4*)(H + (size_t)r1 * DM + col) = w1[0]; *(u32x4*)(H + (size_t)r1 * DM + col + 8) = w1[1]; }
        } else {
#pragma unroll
            for (int q = 0; q < 4; ++q) { const f32x4 gg = *(const f32x4*)(g + col + 4 * q);
                const f32x4 x0 = {v0[4 * q], v0[4 * q + 1], v0[4 * q + 2], v0[4 * q + 3]}, x1 = {v1[4 * q], v1[4 * q + 1], v1[4 * q + 2], v1[4 * q + 3]};
                *(f32x4*)(out + (size_t)r0 * DM + col + 4 * q) = x0 * rstd0 * gg; if (has1) *(f32x4*)(out + (size_t)r1 * DM + col + 4 * q) = x1 * rstd1 * gg; }
        }
    }
}

namespace pg8 {
constexpr int BM = 256, BK = 64, HALF = 128, HTB = HALF * BK * 2, STAGE_BYTES = 8 * HTB, NXCD = 8, WGM = 8;
DI int lds_byte(int r, int c) { const int st = (r >> 4) * 2 + (c >> 5), rr = r & 15, cc = c & 31, ob = rr * 64 + cc * 2; return st * 1024 + (ob ^ (((ob >> 9) & 1) << 5)); }
DI void stage_rc(int b, int& R, int& C) { const int st = b / 1024, sb = b % 1024, swz = sb ^ (((sb >> 9) & 1) << 5); R = (st >> 1) * 16 + swz / 64; C = (st & 1) * 32 + (swz % 64) / 2; }
DI int perm32(int rho) { const int n = rho >> 4, i = rho & 15; return 8 * (i >> 2) + 4 * n + (i & 3); }
struct Unit { int pm, pn, half; };
struct Gemm { const bf16_t* A; const bf16_t* Bt; int M, N, K; };
struct StaticOrder {
    int nM, nN, nwg, G, c, nhalf;
    DI void init(int M, int N, int G_, int c_) { nM = M / BM; nN = N / BM; nwg = nM * nN; G = G_; c = c_; nhalf = 0; }
    DI bool next(int i, Unit& u) const {
        const long L = (long)i * G + c; u.half = -1;
        if (L >= nwg) { const int k = (int)(L - nwg); if (k >= nhalf) return false; u.half = k & 1; u.pm = 128 + (k >> 1) / nN; u.pn = (k >> 1) % nN; return true; }
        int wgid = (int)L; { const int q = nwg / NXCD, r = nwg % NXCD, xcd = wgid % NXCD, off = wgid / NXCD; wgid = (xcd < r ? xcd * (q + 1) : r * (q + 1) + (xcd - r) * q) + off; }
        const int nig = WGM * nN, gid = wgid / nig, fm = gid * WGM, gsz = (nM - fm) < WGM ? (nM - fm) : WGM;
        u.pm = fm + ((wgid % nig) % gsz); u.pn = (wgid % nig) / gsz; return true;
    }
};
enum { EPI_EVEN_IN = 0, EPI_RESID = 1, EPI_SWIGLU = 2, EPI_ODD_IN = 3 };
struct Epi { int mode; unsigned char* ws; const float* gate; };

DI void epilogue(const f32x4 (&acc)[2][2][4][2], const Unit& u, int wr, int wc, int fr_in, int fq_in, const Epi& E) {
    int fr = fr_in, fq = fq_in; asm volatile("" : "+v"(fr), "+v"(fq));
    bf16_t* const E_O = (bf16_t*)(E.ws + WS_P); bf16_t* const E_xb = (bf16_t*)(E.ws + WS_X); const float* const E_rope = (const float*)(E.ws + WS_ROPE);
    if (E.mode == EPI_RESID) {
        bf16_t* X = E_xb + ((size_t)u.pm * 256 + (u.half == 1 ? HALF : 0)) * DM;
        const int s = u.pm < 128 ? (u.pm >> 5) : 4; const int nai = u.half >= 0 ? 1 : 2;
#pragma unroll
        for (int bj = 0; bj < 2; ++bj) { const int col0 = u.pn * BM + bj * HALF + wc * 32 + 8 * fq;
            const f32x4 gv0 = *(const f32x4*)(E.gate + (size_t)s * 6144 + col0), gv1 = *(const f32x4*)(E.gate + (size_t)s * 6144 + col0 + 4);
            u32x4 xin[2][4];
#pragma unroll
            for (int ai = 0; ai < 2; ++ai)
#pragma unroll
                for (int m = 0; m < 4; ++m) if (ai < nai) xin[ai][m] = *(const u32x4*)(X + (size_t)(ai * HALF + wr * 64 + m * 16 + fr) * DM + col0);
#pragma unroll
            for (int ai = 0; ai < 2; ++ai)
#pragma unroll
                for (int m = 0; m < 4; ++m) { const u32x4 xi = xin[ai][m]; const f32x4 a0 = acc[ai][bj][m][0], a1 = acc[ai][bj][m][1]; u32x4 w;
                    w[0] = pk2(bflo(xi[0]) + gv0[0] * a0[0], bfhi(xi[0]) + gv0[1] * a0[1]); w[1] = pk2(bflo(xi[1]) + gv0[2] * a0[2], bfhi(xi[1]) + gv0[3] * a0[3]);
                    w[2] = pk2(bflo(xi[2]) + gv1[0] * a1[0], bfhi(xi[2]) + gv1[1] * a1[1]); w[3] = pk2(bflo(xi[3]) + gv1[2] * a1[2], bfhi(xi[3]) + gv1[3] * a1[3]);
                    if (ai < nai) *(u32x4*)(X + (size_t)(ai * HALF + wr * 64 + m * 16 + fr) * DM + col0) = w; }
            asm volatile("" ::: "memory"); }
    } else if (E.mode == EPI_SWIGLU) {
        const int f0 = u.pn * 128 + wc * 32 + 8 * fq;
#pragma unroll
        for (int ai = 0; ai < 2; ++ai)
#pragma unroll
            for (int m = 0; m < 4; ++m) { const size_t row = (size_t)u.pm * BM + ai * HALF + wr * 64 + m * 16 + fr;
                const f32x4 g0 = acc[ai][0][m][0], g1 = acc[ai][0][m][1], u0 = acc[ai][1][m][0], u1 = acc[ai][1][m][1];
                u32x4 w; w[0] = pk2(siluf_(g0[0]) * u0[0], siluf_(g0[1]) * u0[1]); w[1] = pk2(siluf_(g0[2]) * u0[2], siluf_(g0[3]) * u0[3]);
                w[2] = pk2(siluf_(g1[0]) * u1[0], siluf_(g1[1]) * u1[1]); w[3] = pk2(siluf_(g1[2]) * u1[2], siluf_(g1[3]) * u1[3]);
                *(u32x4*)(E_O + row * DFF + f0) = w; }
    } else if (E.mode == EPI_ODD_IN) {
#pragma unroll
        for (int bj = 0; bj < 2; ++bj) { const int col0 = u.pn * BM + bj * HALF + wc * 32 + 8 * fq; const float sc = col0 < 256 ? 0.125f : 1.0f;
#pragma unroll
            for (int ai = 0; ai < 2; ++ai)
#pragma unroll
                for (int m = 0; m < 4; ++m) { const size_t row = (size_t)u.pm * BM + ai * HALF + wr * 64 + m * 16 + fr;
                    const f32x4 v0 = acc[ai][bj][m][0] * sc, v1 = acc[ai][bj][m][1] * sc;
                    u32x4 w; w[0] = pk2(v0[0], v0[1]); w[1] = pk2(v0[2], v0[3]); w[2] = pk2(v1[0], v1[1]); w[3] = pk2(v1[2], v1[3]);
                    if (col0 < 2592) *(u32x4*)(E_O + row * OINP + col0) = w; } }
    } else {
        const bool latent = u.pm < 128;
#pragma unroll
        for (int bj = 0; bj < 2; ++bj) { const int cb = u.pn * BM + bj * HALF + wc * 32;
            const bool roped = latent && (cb < 1024 || (cb >= 1536 && cb < 2176));
            const float qs = (cb < 512 || (cb >= 1536 && cb < 2048)) ? 0.125f * LOG2E : 1.0f;
            const int half = (cb >> 5) & 1;
#pragma unroll
            for (int ai = 0; ai < 2; ++ai)
#pragma unroll
                for (int m = 0; m < 4; ++m) { const int rl = ai * HALF + wr * 64 + m * 16 + fr; const size_t row = (size_t)u.pm * BM + rl;
                    f32x4 x1 = acc[ai][bj][m][0], x2 = acc[ai][bj][m][1];
                    if (roped) { const int t = ((u.pm & 31) << 8) + rl; const int pos = half ? (t & 63) : (t >> 6);
                        const f32x4 t0 = *(const f32x4*)(E_rope + (pos * 16 + 4 * fq) * 2), t1 = *(const f32x4*)(E_rope + (pos * 16 + 4 * fq) * 2 + 4);
                        const f32x4 cs = {t0[0], t0[2], t1[0], t1[2]}, sn = {t0[1], t0[3], t1[1], t1[3]};
                        const f32x4 o1 = x1 * cs - x2 * sn, o2 = x1 * sn + x2 * cs; x1 = o1; x2 = o2; }
                    x1 *= qs; x2 *= qs;
                    u32x2 w1, w2; w1[0] = pk2(x1[0], x1[1]); w1[1] = pk2(x1[2], x1[3]); w2[0] = pk2(x2[0], x2[1]); w2[1] = pk2(x2[2], x2[3]);
                    *(u32x2*)(E_O + row * EIN + cb + 4 * fq) = w1; *(u32x2*)(E_O + row * EIN + cb + 16 + 4 * fq) = w2; } }
    }
}

DI void gemm_phase(LAS unsigned char* lds, const Gemm g, const StaticOrder& S, const Epi& E, int wv_) {
    const int tid = otid(), wid = __builtin_amdgcn_readfirstlane(tid >> 6), lane = tid & 63, wr = wid >> 2, wc = wid & 3, fr = lane & 15, fq = lane >> 4;
    const int K = g.K, nt = K / BK;
    const bool perm = (E.mode != EPI_EVEN_IN);
    unsigned voffA[2], voffB[2];
#pragma unroll
    for (int i = 0; i < 2; ++i) { int R, C; stage_rc(tid * 16 + i * 8192, R, C); const int Rb = perm ? ((R & ~31) + perm32(R & 31)) : R;
        voffA[i] = (unsigned)(R * K + C) * 2u; voffB[i] = (unsigned)(Rb * K + C) * 2u; }
    const size_t kstep = (size_t)(BK * 2);
    const size_t hstep = (size_t)HALF * K * 2;
    const size_t tstep = 2 * hstep;
    const unsigned ldsw = (unsigned)wid * 1024u;
    const int aoff = lds_byte(wr * 64 + fr, fq * 8), boff = lds_byte(wc * 32 + fr, fq * 8);
#define PG8_SA(b, h) (((b) * 2 + (h)) * HTB)
#define PG8_SB(b, h) ((4 + (b) * 2 + (h)) * HTB)
#define PG8_STAGE(bufoff, gbase, voff) do { _Pragma("unroll") for (int _i = 0; _i < 2; ++_i) \
        __builtin_amdgcn_global_load_lds((const unsigned*)((const char*)(gbase) + (voff)[_i]), (LAS unsigned*)(lds + (bufoff) + ldsw + _i * 8192), 16, 0, 0); } while (0)
#define PG8_LDA(dst, b, h) do { _Pragma("unroll") for (int m = 0; m < 4; ++m) _Pragma("unroll") for (int k = 0; k < 2; ++k) dst[m][k] = *(const LAS bf16x8*)(lds + PG8_SA(b, h) + aoff + m * 2048 + k * 1024); } while (0)
#define PG8_LDB(dst, b, h) do { _Pragma("unroll") for (int n = 0; n < 2; ++n) _Pragma("unroll") for (int k = 0; k < 2; ++k) dst[n][k] = *(const LAS bf16x8*)(lds + PG8_SB(b, h) + boff + n * 2048 + k * 1024); } while (0)
#define PG8_MMA(ai, bj, At, Bt) do { __builtin_amdgcn_s_setprio(1); _Pragma("unroll") for (int m = 0; m < 4; ++m) _Pragma("unroll") for (int n = 0; n < 2; ++n) _Pragma("unroll") for (int k = 0; k < 2; ++k) \
        acc[ai][bj][m][n] = __builtin_amdgcn_mfma_f32_16x16x32_bf16(Bt[n][k], At[m][k], acc[ai][bj][m][n], 0, 0, 0); __builtin_amdgcn_s_setprio(0); } while (0)
#define PG8_WAIT_V(n) asm volatile("s_waitcnt vmcnt(" #n ")" ::: "memory")
#define PG8_WAIT_L(n) asm volatile("s_waitcnt lgkmcnt(" #n ")" ::: "memory")
#define PG8_BAR __builtin_amdgcn_s_barrier()
#define PG8_SCHED __builtin_amdgcn_sched_barrier(0)
    Unit cur, nxt; int ui = 0;
    if (!S.next(0, cur)) return;
    f32x4 acc[2][2][4][2];
#pragma unroll
    for (int a = 0; a < 2; ++a)
#pragma unroll
        for (int b = 0; b < 2; ++b)
#pragma unroll
            for (int m = 0; m < 4; ++m)
#pragma unroll
                for (int n = 0; n < 2; ++n) acc[a][b][m][n] = (f32x4){0.f, 0.f, 0.f, 0.f};
    bf16x8 At[4][2], B0[2][2], B1[2][2];
    const char* cA = (const char*)g.A + (size_t)cur.pm * tstep + (cur.half == 1 ? hstep : 0); const char* cB = (const char*)g.Bt + (size_t)cur.pn * tstep;
    PG8_STAGE(PG8_SB(0, 0), cB, voffB); PG8_STAGE(PG8_SA(0, 0), cA, voffA); PG8_STAGE(PG8_SB(0, 1), cB + hstep, voffB); PG8_STAGE(PG8_SA(0, 1), cA + hstep, voffA);
    if (wr == 1) PG8_BAR;
    PG8_WAIT_V(4); PG8_BAR;
    PG8_STAGE(PG8_SB(1, 0), cB + kstep, voffB); PG8_STAGE(PG8_SA(1, 0), cA + kstep, voffA); PG8_STAGE(PG8_SB(1, 1), cB + hstep + kstep, voffB);
    PG8_WAIT_V(6); PG8_BAR;
    for (;;) {
        const bool has_next = S.next(ui + 1, nxt);
        const char* nA = has_next ? (const char*)g.A + (size_t)nxt.pm * tstep + (nxt.half == 1 ? hstep : 0) : cA; const char* nB = has_next ? (const char*)g.Bt + (size_t)nxt.pn * tstep : cB;
        const bool hm = cur.half >= 0;
        for (int t = 0; t < nt; t += 2) {
            const bool last = (t == nt - 2);
            const char* a1 = cA + (size_t)(t + 1) * kstep;
            const char* a2 = last ? nA : cA + (size_t)(t + 2) * kstep; const char* b2 = last ? nB : cB + (size_t)(t + 2) * kstep;
            const char* a3 = a2 + kstep; const char* b3 = b2 + kstep;
            PG8_LDB(B0, 0, 0); PG8_SCHED; PG8_LDA(At, 0, 0); PG8_STAGE(PG8_SA(1, 1), a1 + hstep, voffA);
            PG8_WAIT_L(8); PG8_BAR; PG8_WAIT_L(0); PG8_MMA(0, 0, At, B0); PG8_BAR; PG8_SCHED;
            PG8_LDB(B1, 0, 1); PG8_STAGE(PG8_SB(0, 0), b2, voffB);
            PG8_BAR; PG8_WAIT_L(0); PG8_MMA(0, 1, At, B1); PG8_BAR;
            if (!hm) PG8_LDA(At, 0, 1); PG8_STAGE(PG8_SA(0, 0), a2, voffA);
            PG8_BAR; PG8_WAIT_L(0); if (!hm) PG8_MMA(1, 0, At, B0); PG8_BAR; PG8_SCHED;
            PG8_STAGE(PG8_SB(0, 1), b2 + hstep, voffB);
            PG8_WAIT_V(6); PG8_BAR; if (!hm) PG8_MMA(1, 1, At, B1); PG8_BAR;
            PG8_LDB(B0, 1, 0); PG8_SCHED; PG8_LDA(At, 1, 0); PG8_STAGE(PG8_SA(0, 1), a2 + hstep, voffA);
            PG8_WAIT_L(8); PG8_BAR; PG8_WAIT_L(0); PG8_MMA(0, 0, At, B0); PG8_BAR; PG8_SCHED;
            PG8_LDB(B1, 1, 1); PG8_STAGE(PG8_SB(1, 0), b3, voffB);
            PG8_BAR; PG8_WAIT_L(0); PG8_MMA(0, 1, At, B1); PG8_BAR;
            if (!hm) PG8_LDA(At, 1, 1); PG8_STAGE(PG8_SA(1, 0), a3, voffA);
            PG8_BAR; PG8_WAIT_L(0); if (!hm) PG8_MMA(1, 0, At, B0); PG8_BAR; PG8_SCHED;
            PG8_STAGE(PG8_SB(1, 1), b3 + hstep, voffB);
            PG8_WAIT_V(6); PG8_BAR; if (!hm) PG8_MMA(1, 1, At, B1); PG8_BAR;
        }
        epilogue(acc, cur, wr, wc, fr, fq, E);
        if (!has_next) break;
#pragma unroll
        for (int a = 0; a < 2; ++a)
#pragma unroll
            for (int b = 0; b < 2; ++b)
#pragma unroll
                for (int m = 0; m < 4; ++m)
#pragma unroll
                    for (int n = 0; n < 2; ++n) acc[a][b][m][n] = (f32x4){0.f, 0.f, 0.f, 0.f};
        cur = nxt; cA = nA; cB = nB; ++ui;
    }
    PG8_WAIT_V(0);
    if (wr == 0) PG8_BAR;
    PG8_BAR;
#undef PG8_SA
#undef PG8_SB
#undef PG8_STAGE
#undef PG8_LDA
#undef PG8_LDB
#undef PG8_MMA
#undef PG8_WAIT_V
#undef PG8_WAIT_L
#undef PG8_BAR
#undef PG8_SCHED
}
}

template <int DV, bool WIN>
DI void attn_unit(LAS unsigned char* lds, const bf16_t* __restrict__ P, bf16_t* __restrict__ MIX, int b, int hh, int qblk, bool ctxq, float lam, const float* __restrict__ sink, int wv_) {
    constexpr int KW = WIN ? 64 : 128, KP = KW * 2 + 16, VP = DV == 128 ? 320 : 192  , KCH = KW / 8, VCH = DV / 8, KN = 64 * KCH / NTHR, VN = 64 * VCH / NTHR, NDT = DV / 32;
    const int tid = otid(), lane = tid & 63, w = __builtin_amdgcn_readfirstlane(tid >> 6), l31 = lane & 31, h = lane >> 5;
    const int base_row = ctxq ? ML + b * LC : b * LQ, crow0 = ML + b * LC, lrow0 = b * LQ;
    int qrow0, qcol, kcol, koff, vcol, lt0 = 0, nlt = 0, qpos0 = 0; float m_run, l_run;
    if (!WIN) { const int rg = w & 3, st = w >> 2; qrow0 = base_row + qblk * 128 + rg * 32; qcol = hh * 128 + st * 64; kcol = 512 + hh * 128; koff = st * 64; vcol = 1024 + hh * 128;
        m_run = -1e30f; l_run = 0.f; if (!ctxq) { lt0 = 0; nlt = 128; } }
    else { const int g = w & 3, rg = w >> 2; qrow0 = base_row + qblk * 64 + rg * 32; qcol = 1536 + (hh * 4 + g) * 64; kcol = 2048 + hh * 64; koff = 0; vcol = 2176 + hh * 64;
        m_run = sink[hh * 4 + g] * LOG2E; l_run = h == 0 ? 1.f : 0.f; qpos0 = qblk * 64 + rg * 32;
        if (!ctxq) { lt0 = qblk - 2 < 0 ? 0 : qblk - 2; const int lt1 = qblk + 2 > 127 ? 127 : qblk + 2; nlt = lt1 - lt0 + 1; } }
    const int ntile = 4 + nlt;
    constexpr int IMGB = 64 * (KP + VP), NS = (IMGB + 8191) / 8192, IMG = NS * 8192;
    static_assert(3 * IMG <= LDS_BYTES - 16 && (NS == 5 || NS == 3), "attention LDS ring");
    unsigned goff[NS];
#pragma unroll
    for (int j = 0; j < NS; ++j) { const int o = (w + 8 * j) * 1024 + lane * 16; unsigned g = 0u;
        if (o < 64 * KP) { const int row = o / KP, cb = o % KP; if (cb < KW * 2) g = (unsigned)((row * EIN + kcol) * 2 + cb); }
        else if (o < IMGB) { const int o2 = o - 64 * KP, row = o2 / VP, cb = o2 % VP; if (cb < DV * 2) g = (unsigned)((row * EIN + vcol) * 2 + cb); }
        goff[j] = g; }
#define ATT_TROW(ti) ((ti) < 4 ? crow0 + 64 * (ti) : lrow0 + 64 * (lt0 + (ti) - 4))
#define ATT_DMA(ti, rb) do { const char* gb_ = (const char*)P + (size_t)ATT_TROW(ti) * (EIN * 2); \
        _Pragma("unroll") for (int j = 0; j < NS; ++j) __builtin_amdgcn_global_load_lds((const unsigned*)(gb_ + goff[j]), (LAS unsigned*)(lds + (rb) * IMG + (w + 8 * j) * 1024), 16, 0, 0); } while (0)
#define ATT_WAIT_TILE() do { if (NS == 5) asm volatile("s_waitcnt vmcnt(5)" ::: "memory"); else asm volatile("s_waitcnt vmcnt(3)" ::: "memory"); } while (0)
#define ATT_BAR() do { __builtin_amdgcn_s_barrier(); asm volatile("" ::: "memory"); } while (0)
    bf16x8 qf[4];
#pragma unroll
    for (int ks = 0; ks < 4; ++ks) qf[ks] = *(const bf16x8*)(P + (size_t)(qrow0 + l31) * EIN + qcol + 16 * ks + 8 * h);
    f32x16 o[NDT];
#pragma unroll
    for (int dt = 0; dt < NDT; ++dt) o[dt] = zero16();
    bf16x8 pf[4];
    bool first = !WIN;
    if (!WIN) m_run = 0.f;
#define ATT_PHASE1(ti) do { LAS unsigned char* Kb = lds + rb_ * IMG; \
        f32x16 s0, s1; _Pragma("unroll") for (int i = 0; i < 16; ++i) { s0[i] = -m_run; s1[i] = -m_run; } \
        _Pragma("unroll") for (int ks = 0; ks < 4; ++ks) { \
            const bf16x8 a0 = *(const LAS bf16x8*)(Kb + l31 * KP + (koff + 16 * ks + 8 * h) * 2); \
            const bf16x8 a1 = *(const LAS bf16x8*)(Kb + (32 + l31) * KP + (koff + 16 * ks + 8 * h) * 2); \
            s0 = MFMA32(a0, qf[ks], s0); s1 = MFMA32(a1, qf[ks], s1); } \
        if (WIN && (ti) >= 4) { const int kt0 = 64 * (lt0 + (ti) - 4), qpos = qpos0 + l31; \
            _Pragma("unroll") for (int i = 0; i < 16; ++i) { const int d0 = kt0 + crow(i, h) - qpos, d1 = d0 + 32; \
                if (d0 > 128 || d0 < -128) s0[i] = -1e30f; if (d1 > 128 || d1 < -128) s1[i] = -1e30f; } } \
        float mx = s0[0]; \
        _Pragma("unroll") for (int i = 1; i < 16; ++i) mx = fmaxf(mx, s0[i]); \
        _Pragma("unroll") for (int i = 0; i < 16; ++i) mx = fmaxf(mx, s1[i]); \
        mx = fmaxf(mx, shx(mx, 32, lane)); \
        if (first || __builtin_amdgcn_ballot_w64(mx > 8.0f) != 0ull) { \
            const float d = first ? mx : fmaxf(mx, 0.f), alpha = __builtin_amdgcn_exp2f(-d); m_run += d; l_run *= alpha; first = false; \
            _Pragma("unroll") for (int dt = 0; dt < NDT; ++dt) o[dt] *= alpha; \
            _Pragma("unroll") for (int i = 0; i < 16; ++i) { s0[i] -= d; s1[i] -= d; } } \
        float rs = 0.f; \
        _Pragma("unroll") for (int i = 0; i < 16; ++i) { s0[i] = __builtin_amdgcn_exp2f(s0[i]); s1[i] = __builtin_amdgcn_exp2f(s1[i]); rs += s0[i] + s1[i]; } \
        l_run += rs; \
        pf[0] = pack8(s0, 0); pf[1] = pack8(s0, 1); pf[2] = pack8(s1, 0); pf[3] = pack8(s1, 1); } while (0)
#define ATT_PHASE2(ti) do { LAS unsigned char* Vb = lds + rb_ * IMG + 64 * KP; \
        _Pragma("unroll") for (int kk = 0; kk < 4; ++kk) { const int kb = 16 * kk; \
            _Pragma("unroll") for (int dt = 0; dt < NDT; ++dt) { const bf16x8 vf = tr_frag(Vb, VP, kb + 4 * h, kb + 8 + 4 * h, 32 * dt + 16 * ((lane >> 4) & 1), lane); o[dt] = MFMA32(vf, pf[kk], o[dt]); } } } while (0)
    ATT_DMA(0, 0); ATT_DMA(1, 1);
    ATT_WAIT_TILE(); ATT_BAR();
    { int rb_ = 0;
      for (int ti = 0; ti < ntile; ++ti) {
          const int rb2 = rb_ >= 1 ? rb_ - 1 : 2;
          if (ti + 2 < ntile) ATT_DMA(ti + 2, rb2);
          ATT_PHASE1(ti); ATT_PHASE2(ti);
          if (ti + 2 < ntile) ATT_WAIT_TILE(); else asm volatile("s_waitcnt vmcnt(0)" ::: "memory");
          ATT_BAR();
          rb_ = rb_ == 2 ? 0 : rb_ + 1; } }
#undef ATT_PHASE1
#undef ATT_PHASE2
#undef ATT_TROW
#undef ATT_DMA
#undef ATT_WAIT_TILE
#undef ATT_BAR
    const float l_tot = l_run + shx(l_run, 32, lane), inv_l = 1.0f / l_tot;
    if (WIN) { const int g = w & 3; bf16_t* orow = MIX + (size_t)(qrow0 + l31) * DM + 512 + (hh * 4 + g) * 64;
#pragma unroll
        for (int dt = 0; dt < NDT; ++dt)
#pragma unroll
            for (int g4 = 0; g4 < 4; ++g4) { u32x2 wv; wv[0] = pk2(o[dt][4 * g4] * inv_l, o[dt][4 * g4 + 1] * inv_l); wv[1] = pk2(o[dt][4 * g4 + 2] * inv_l, o[dt][4 * g4 + 3] * inv_l);
                *(u32x2*)(orow + 32 * dt + 8 * g4 + 4 * h) = wv; }
    } else {
        const int rg = w & 3, st = w >> 2; LAS float* comb = (LAS float*)lds;
        if (st == 1) {
#pragma unroll
            for (int dt = 0; dt < NDT; ++dt)
#pragma unroll
                for (int i = 0; i < 16; ++i) comb[(rg * 128 + 32 * dt + crow(i, h)) * 32 + l31] = o[dt][i] * inv_l;
        }
        __syncthreads();
        if (st == 0) { float ss = 0.f;
#pragma unroll
            for (int dt = 0; dt < NDT; ++dt)
#pragma unroll
                for (int i = 0; i < 16; ++i) { const float d = o[dt][i] * inv_l - lam * comb[(rg * 128 + 32 * dt + crow(i, h)) * 32 + l31]; o[dt][i] = d; ss += d * d; }
            ss += shx(ss, 32, lane);
            const float sc = rsqrtf(ss * (1.0f / 128.0f) + 1e-6f) * 0.8f;
            bf16_t* orow = MIX + (size_t)(qrow0 + l31) * DM + hh * 128;
#pragma unroll
            for (int dt = 0; dt < NDT; ++dt)
#pragma unroll
                for (int g4 = 0; g4 < 4; ++g4) { u32x2 wv; wv[0] = pk2(o[dt][4 * g4] * sc, o[dt][4 * g4 + 1] * sc); wv[1] = pk2(o[dt][4 * g4 + 2] * sc, o[dt][4 * g4 + 3] * sc);
                    *(u32x2*)(orow + 32 * dt + 8 * g4 + 4 * h) = wv; }
        }
        __syncthreads();
    }
}
DI void attn_phase(LAS unsigned char* lds, const Params& p, int G, int bid, int wv_) {
    const bf16_t* P = (const bf16_t*)(p.ws + WS_P); bf16_t* MIX = (bf16_t*)(p.ws + WS_MIX);
    const float lam = ((const float*)(p.ws + WS_SCAL))[0]; const float* sink = ((const float*)(p.ws + WS_SMALL)) + SM_SINK;
    for (int u = bid; u < 2112; u += G) {
        if (u < 1024) { int qb = u & 63, bh = u >> 6;
            if (G == 256) { const int r = u >> 8, xcd = u & 7, j = (u & 255) >> 3; bh = 2 * xcd + (r >> 1); qb = (r & 1) * 32 + j; }
            attn_unit<128, false>(lds, P, MIX, bh >> 2, bh & 3, qb, false, lam, sink, wv_); }
        else if (u < 2048) { const int v = u - 1024, qb = v & 127, bk = v >> 7; attn_unit<64, true>(lds, P, MIX, bk >> 1, bk & 1, qb, false, lam, sink, wv_); }
        else if (u < 2080) { const int v = u - 2048, qb = v & 1, bh = v >> 1; attn_unit<128, false>(lds, P, MIX, bh >> 2, bh & 3, qb, true, lam, sink, wv_); }
        else { const int v = u - 2080, qb = v & 3, bk = v >> 2; attn_unit<64, true>(lds, P, MIX, bk >> 1, bk & 1, qb, true, lam, sink, wv_); }
    }
}

constexpr int GV_LR = 0, GV_V = 8192, GV_SCR = GV_V + 4 * 64 * 320, GV_END = GV_SCR + 8 * 4608;
static_assert(GV_END <= LDS_BYTES - 16, "GLA LDS map");
DI void gla_load_v(LAS unsigned char* lds, const bf16_t* __restrict__ P1, int row0, int tid) {
#pragma unroll
    for (int j = 0; j < 8; ++j) { const int id = tid + NTHR * j, r = id >> 6, c = id & 63;
        *(LAS u32x4*)(lds + GV_V + (c >> 4) * (64 * 320) + r * 320 + (c & 15) * 16) = *(const u32x4*)(P1 + (size_t)(row0 + r) * OINP + 512 + c * 8); }
}
DI void gla_pass1(LAS unsigned char* lds, const Params& p, int item, int wv_) {
    const int cid = item % NCH, b = item / NCH;
    const int tid = otid(), lane = tid & 63, w = __builtin_amdgcn_readfirstlane(tid >> 6), l31 = lane & 31, h = lane >> 5;
    const int dir = w >> 2, hd = w & 3, seq = (b * 2 + dir) * 4 + hd, d = lane;
    const bf16_t* P1 = (const bf16_t*)(p.ws + WS_P); const int row0 = chunk_row0(b, cid);
    const float* SM = (const float*)(p.ws + WS_SMALL);
    LAS unsigned char* QK = lds + GV_V;
    LAS bf16_t* SCR = (LAS bf16_t*)(lds + GV_SCR + w * 4608);
#pragma unroll
    for (int j = 0; j < 8; ++j) { const int id = tid + NTHR * j, r = id >> 6, c = id & 63; *(LAS u32x4*)(QK + r * 1040 + c * 16) = *(const u32x4*)(P1 + (size_t)(row0 + r) * OINP + c * 8); }
    bf16x8 la[2], gwb[2];
#pragma unroll
    for (int mt = 0; mt < 2; ++mt) la[mt] = *(const bf16x8*)(P1 + (size_t)(row0 + 32 * mt + l31) * OINP + 1536 + dir * 16 + 8 * h);
#pragma unroll
    for (int nt = 0; nt < 2; ++nt) { u32x4 pk;
#pragma unroll
        for (int j = 0; j < 4; ++j) pk[j] = pk2(SM[SM_GGW + (dir * 16 + 8 * h + 2 * j) * 256 + hd * 64 + 32 * nt + l31], SM[SM_GGW + (dir * 16 + 8 * h + 2 * j + 1) * 256 + hd * 64 + 32 * nt + l31]);
        gwb[nt] = __builtin_bit_cast(bf16x8, pk); }
    const float gb = SM[SM_GGB + dir * 256 + hd * 64 + d];
    __syncthreads();
    u32x4 vreg[8];
#pragma unroll
    for (int j = 0; j < 8; ++j) { const int id = tid + NTHR * j, r = id >> 6, c = id & 63; vreg[j] = *(const u32x4*)(P1 + (size_t)(row0 + r) * OINP + 512 + c * 8); }
    float g[64];
#pragma unroll
    for (int mt = 0; mt < 2; ++mt) { f32x16 c0 = MFMA32(la[mt], gwb[0], zero16()), c1 = MFMA32(la[mt], gwb[1], zero16());
#pragma unroll
        for (int r = 0; r < 16; ++r) { const auto sw = __builtin_amdgcn_permlane32_swap(__float_as_uint(c0[r]), __float_as_uint(c1[r]), false, false);
            const float x = __uint_as_float(sw[0]), y = __uint_as_float(sw[1]); const int t0 = 32 * mt + 8 * (r >> 2) + (r & 3);
            g[t0] = log_sigmoidf_(x + gb) * (1.0f / 16.0f); g[t0 + 4] = log_sigmoidf_(y + gb) * (1.0f / 16.0f); } }
    if (dir == 0) {
#pragma unroll
        for (int i = 1; i < 64; ++i) g[i] += g[i - 1];
    } else {
#pragma unroll
        for (int i = 62; i >= 0; --i) g[i] += g[i + 1];
    }
    const float blast = dir ? g[0] : g[63], eb = __expf(blast);
    ((float*)(p.ws + WS_GDEC))[((size_t)seq * NCH + cid) * 64 + d] = eb;
    bf16_t* QT = (bf16_t*)(p.ws + WS_QT); bf16_t* KT = (bf16_t*)(p.ws + WS_KT);
    u32x4 own[8];
#pragma unroll
    for (int th = 0; th < 2; ++th) {
#pragma unroll
        for (int ii = 0; ii < 32; ++ii) { const int i = 32 * th + ii; g[i] = __expf(g[i]);
            SCR[ii * 72 + d] = f2bf(bf2f(*(const LAS bf16_t*)(QK + i * 1040 + (hd * 64 + d) * 2)) * g[i]); }
#pragma unroll
        for (int j = 0; j < 4; ++j) { const int tk = (lane >> 3) + 8 * j, sg = lane & 7; const u32x4 v = *(const LAS u32x4*)(SCR + tk * 72 + sg * 8);
            *(u32x4*)(QT + ((size_t)(row0 + 32 * th + tk) * 2 + dir) * 256 + hd * 64 + sg * 8) = v; }
#pragma unroll
        for (int ii = 0; ii < 32; ii += 2) { const int i = 32 * th + ii;
            const float k0 = bf2f(*(const LAS bf16_t*)(QK + i * 1040 + (256 + hd * 64 + d) * 2)) * __builtin_amdgcn_rcpf(g[i]);
            const float k1 = bf2f(*(const LAS bf16_t*)(QK + (i + 1) * 1040 + (256 + hd * 64 + d) * 2)) * __builtin_amdgcn_rcpf(g[i + 1]);
            SCR[ii * 72 + d] = f2bf(k0); SCR[(ii + 1) * 72 + d] = f2bf(k1);
            own[i >> 3][(i & 7) >> 1] = pk2(k0 * eb, k1 * eb); }
#pragma unroll
        for (int j = 0; j < 4; ++j) { const int tk = (lane >> 3) + 8 * j, sg = lane & 7; const u32x4 v = *(const LAS u32x4*)(SCR + tk * 72 + sg * 8);
            *(u32x4*)(KT + ((size_t)(row0 + 32 * th + tk) * 2 + dir) * 256 + hd * 64 + sg * 8) = v; }
    }
    bf16x8 fr[4][2];
#pragma unroll
    for (int ks = 0; ks < 4; ++ks) { u32x4 a = own[2 * ks], bb = own[2 * ks + 1];
#pragma unroll
        for (int j = 0; j < 4; ++j) { const auto r = __builtin_amdgcn_permlane32_swap(a[j], bb[j], false, false); a[j] = r[0]; bb[j] = r[1]; }
        fr[ks][0] = __builtin_bit_cast(bf16x8, a); fr[ks][1] = __builtin_bit_cast(bf16x8, bb); }
    __syncthreads();
#pragma unroll
    for (int j = 0; j < 8; ++j) { const int id = tid + NTHR * j, r = id >> 6, c = id & 63; *(LAS u32x4*)(lds + GV_V + (c >> 4) * (64 * 320) + r * 320 + (c & 15) * 16) = vreg[j]; }
    __syncthreads();
    LAS unsigned char* Vt = lds + GV_V + hd * (64 * 320);
    bf16_t* St = (bf16_t*)(p.ws + WS_H) + ((size_t)seq * NCH + cid) * 8192;
#pragma unroll
    for (int et = 0; et < 4; ++et) { f32x16 a0 = zero16(), a1 = zero16();
#pragma unroll
        for (int ks = 0; ks < 4; ++ks) { const bf16x8 vf = tr_frag(Vt, 320, 16 * ks + 8 * h, 16 * ks + 8 * h + 4, 32 * et + 16 * ((lane >> 4) & 1), lane);
            a0 = MFMA32(vf, fr[ks][0], a0); a1 = MFMA32(vf, fr[ks][1], a1); }
#pragma unroll
        for (int r = 0; r < 16; ++r) { SCR[crow(r, h) * 72 + l31] = f2bf(a0[r]); SCR[crow(r, h) * 72 + 32 + l31] = f2bf(a1[r]); }
#pragma unroll
        for (int j = 0; j < 4; ++j) { const int er = (lane >> 3) + 8 * j, sg = lane & 7; const u32x4 v = *(const LAS u32x4*)(SCR + er * 72 + sg * 8);
            *(u32x4*)(St + (32 * et + er) * 64 + sg * 8) = v; } }
    __syncthreads();
}
DI int scan_cid(int dir, int sidx) { return dir == 0 ? sidx : (sidx < 4 ? 3 - sidx : 135 - sidx); }
DI void gla_scan(const Params& p, int item, int wv_) {
    const int seq = item >> 3, slab = item & 7, dir = (seq >> 2) & 1; const int el = slab * 1024 + otid() * 2, d = el & 63;
    unsigned* St = (unsigned*)((bf16_t*)(p.ws + WS_H) + (size_t)seq * NCH * 8192 + el); const float* dec = (const float*)(p.ws + WS_GDEC) + (size_t)seq * NCH * 64 + d;
    float r0 = 0.f, r1 = 0.f;
    for (int s0 = 0; s0 < NCH; s0 += 12) { unsigned v[12]; f32x2 dc[12];
#pragma unroll
        for (int j = 0; j < 12; ++j) { const int cid = scan_cid(dir, s0 + j); v[j] = St[(size_t)cid * 4096]; dc[j] = *(const f32x2*)(dec + cid * 64); }
#pragma unroll
        for (int j = 0; j < 12; ++j) { const int cid = scan_cid(dir, s0 + j); St[(size_t)cid * 4096] = pk2(r0, r1); r0 = dc[j][0] * r0 + bflo(v[j]); r1 = dc[j][1] * r1 + bfhi(v[j]); } }
}
DI void gla_pass3(LAS unsigned char* lds, const Params& p, int item, int wv_) {
    const int lc = item & 127, b = item >> 7, cid = lc + 4;
    const int tid = otid(), lane = tid & 63, w = __builtin_amdgcn_readfirstlane(tid >> 6), l31 = lane & 31, h = lane >> 5;
    const int hd = w >> 1, it = w & 1;
    const bf16_t* P1 = (const bf16_t*)(p.ws + WS_P); const int row0 = chunk_row0(b, cid);
    const bf16_t* QT = (const bf16_t*)(p.ws + WS_QT); const bf16_t* KT = (const bf16_t*)(p.ws + WS_KT);
    gla_load_v(lds, P1, row0, tid);
    __syncthreads();
    LAS unsigned char* Vt = lds + GV_V + hd * (64 * 320);
    f32x16 o[4];
#pragma unroll
    for (int et = 0; et < 4; ++et) o[et] = zero16();
    const int iq = 32 * it + l31;
    for (int dir = 0; dir < 2; ++dir) {
        const int seq = (b * 2 + dir) * 4 + hd;
        const bf16_t* St = (const bf16_t*)(p.ws + WS_H) + ((size_t)seq * NCH + cid) * 8192;
        bf16x8 qf[4], kf[2][4], sf[4][4];
#pragma unroll
        for (int ks = 0; ks < 4; ++ks) qf[ks] = *(const bf16x8*)(QT + ((size_t)(row0 + iq) * 2 + dir) * 256 + hd * 64 + 16 * ks + 8 * h);
#pragma unroll
        for (int jt = 0; jt < 2; ++jt)
#pragma unroll
            for (int ks = 0; ks < 4; ++ks) kf[jt][ks] = *(const bf16x8*)(KT + ((size_t)(row0 + 32 * jt + l31) * 2 + dir) * 256 + hd * 64 + 16 * ks + 8 * h);
#pragma unroll
        for (int ks = 0; ks < 4; ++ks)
#pragma unroll
            for (int et = 0; et < 4; ++et) sf[ks][et] = *(const bf16x8*)(St + (32 * et + l31) * 64 + 16 * ks + 8 * h);
        __builtin_amdgcn_sched_barrier(0);
#pragma unroll
        for (int jt = 0; jt < 2; ++jt) {
            if (dir == 0 ? (jt > it) : (jt < it)) continue;
            f32x16 at = zero16();
#pragma unroll
            for (int ks = 0; ks < 4; ++ks) at = MFMA32(kf[jt][ks], qf[ks], at);
#pragma unroll
            for (int r = 0; r < 16; ++r) { const int j = 32 * jt + crow(r, h); const bool ok = dir ? (j >= iq) : (j <= iq); at[r] = ok ? at[r] : 0.f; }
#pragma unroll
            for (int s2 = 0; s2 < 2; ++s2) { const bf16x8 pf = pack8(at, s2); const int kb = 32 * jt + 16 * s2;
#pragma unroll
                for (int et = 0; et < 4; ++et) { const bf16x8 vf = tr_frag(Vt, 320, kb + 4 * h, kb + 8 + 4 * h, 32 * et + 16 * ((lane >> 4) & 1), lane); o[et] = MFMA32(vf, pf, o[et]); } }
        }
#pragma unroll
        for (int ks = 0; ks < 4; ++ks)
#pragma unroll
            for (int et = 0; et < 4; ++et) o[et] = MFMA32(sf[ks][et], qf[ks], o[et]);
    }
    float ss = 0.f;
#pragma unroll
    for (int et = 0; et < 4; ++et)
#pragma unroll
        for (int r = 0; r < 16; ++r) ss += o[et][r] * o[et][r];
    ss += shx(ss, 32, lane);
    const float rstd = rsqrtf(ss * (1.0f / 128.0f) + 1e-6f); const float* gng = (const float*)(p.ws + WS_SMALL) + SM_GNG;
    const bf16_t* gp = P1 + (size_t)(row0 + iq) * OINP + 1024 + hd * 128; bf16_t* op = (bf16_t*)(p.ws + WS_MIX) + (size_t)(row0 + iq) * DM + hd * 128;
#pragma unroll
    for (int et = 0; et < 4; ++et)
#pragma unroll
        for (int g4 = 0; g4 < 4; ++g4) { const int e0 = 32 * et + 8 * g4 + 4 * h; const u32x2 gv = *(const u32x2*)(gp + e0); const f32x4 gn = *(const f32x4*)(gng + e0);
            u32x2 wv; wv[0] = pk2(o[et][4 * g4] * rstd * gn[0] * siluf_(bflo(gv[0])), o[et][4 * g4 + 1] * rstd * gn[1] * siluf_(bfhi(gv[0])));
            wv[1] = pk2(o[et][4 * g4 + 2] * rstd * gn[2] * siluf_(bflo(gv[1])), o[et][4 * g4 + 3] * rstd * gn[3] * siluf_(bfhi(gv[1])));
            *(u32x2*)(op + e0) = wv; }
    __syncthreads();
}

constexpr int LR_XR = 0, LR_XB = LR_XR + 128 * 65 * 4, LR_HS = LR_XB + 128 * 144, LR_END = LR_HS + 4 * 64 * 65 * 4;
static_assert(LR_END <= LDS_BYTES - 16 && (LR_XB % 16) == 0, "LRU LDS map");
template <int DIR, bool FINAL>
DI void lru_scan_regs(float (&a)[32], float (&u)[32], float h_in, int h, int lane, float& ptot, float& hend) {
    float PG[8], HG[8], PP[8], HP[8], carry[8];
#pragma unroll
    for (int gi = 0; gi < 8; ++gi) { float P = 1.f, H = 0.f;
#pragma unroll
        for (int s4 = 0; s4 < 4; ++s4) { const int r = (gi >> 2) * 16 + (gi & 3) * 4 + (DIR ? 3 - s4 : s4); H = a[r] * H + u[r]; P *= a[r]; }
        PG[gi] = P; HG[gi] = H; }
#pragma unroll
    for (int gi = 0; gi < 8; ++gi) { PP[gi] = shx(PG[gi], 32, lane); HP[gi] = shx(HG[gi], 32, lane); }
    float hc = h_in, pt = 1.f;
#pragma unroll
    for (int s = 0; s < 16; ++s) { const int G = DIR ? 15 - s : s, gi = G >> 1; const bool mine = ((G & 1) == h);
        const float P = mine ? PG[gi] : PP[gi], H = mine ? HG[gi] : HP[gi];
        if (DIR ? (G & 1) == 1 : (G & 1) == 0) carry[gi] = hc; else carry[gi] = mine ? hc : carry[gi];
        hc = P * hc + H; pt *= P; }
    ptot = pt; hend = hc;
    if (FINAL) {
#pragma unroll
        for (int gi = 0; gi < 8; ++gi) { float hr = carry[gi];
#pragma unroll
            for (int s4 = 0; s4 < 4; ++s4) { const int r = (gi >> 2) * 16 + (gi & 3) * 4 + (DIR ? 3 - s4 : s4); hr = a[r] * hr + u[r]; u[r] = hr; } }
    }
}
template <bool FINAL>
DI void lru_pass(LAS unsigned char* lds, const Params& p, int item, int wv_) {
    const int nbp = item & 3, bc = item >> 2, cid = bc % NCH, b = bc / NCH;
    const int tid = otid(), lane = tid & 63, w = __builtin_amdgcn_readfirstlane(tid >> 6), l31 = lane & 31, h = lane >> 5;
    const bf16_t* P1 = (const bf16_t*)(p.ws + WS_P); const int row0 = chunk_row0(b, cid);
    const int ts = cid < 4 ? cid * 64 : (cid - 4) * 64, seglen = cid < 4 ? LC : LQ, seg_row0 = row0 - ts;
    const float* SM = (const float*)(p.ws + WS_SMALL);
    LAS float* XR = (LAS float*)(lds + LR_XR); LAS bf16_t* XB = (LAS bf16_t*)(lds + LR_XB); LAS float* HS = (LAS float*)(lds + LR_HS);
    const int nbl = w >> 2, dir = (w >> 1) & 1, dh = w & 1, nb = nbp * 2 + nbl, d = 32 * dh + l31, ch = nb * 64 + d;
    const bf16_t* Wa = (const bf16_t*)(p.ws + WS_WGT) + (size_t)((dir * 2 + 0) * 8 + nb) * 4096 + d * 64; const bf16_t* Wx = (const bf16_t*)(p.ws + WS_WGT) + (size_t)((dir * 2 + 1) * 8 + nb) * 4096 + d * 64;
    bf16x8 wa[4], wx[4];
#pragma unroll
    for (int ks = 0; ks < 4; ++ks) { wa[ks] = *(const bf16x8*)(Wa + 16 * ks + 8 * h); wx[ks] = *(const bf16x8*)(Wx + 16 * ks + 8 * h); }
    const float ba = SM[SM_BA + dir * 512 + ch], bx = SM[SM_BX + dir * 512 + ch], lamv = SM[SM_LAM + dir * 512 + ch];
    float h_in = 0.f; const size_t cidx = ((size_t)(b * 2 + dir) * NCH + cid) * 512 + ch;
    if (FINAL) h_in = ((const float*)(p.ws + WS_LRUC))[cidx];
    u32x4 zg0 = {0u, 0u, 0u, 0u}, zg1 = zg0;
    if (FINAL) { const bf16_t* zp = P1 + (size_t)(row0 + (tid >> 3)) * OINP + 1568 + nbp * 128 + (tid & 7) * 16; zg0 = *(const u32x4*)zp; zg1 = *(const u32x4*)(zp + 8); }
    { const int i = tid >> 3, c0 = (tid & 7) * 16, ch0 = nbp * 128 + c0; float acc[16];
#pragma unroll
      for (int j = 0; j < 16; ++j) acc[j] = SM[SM_CB + ch0 + j];
      u32x4 zz[4][2];
#pragma unroll
      for (int tap = 0; tap < 4; ++tap) { const int t = ts + i + tap - 1, tc = t < 0 ? 0 : (t >= seglen ? seglen - 1 : t);
          const bf16_t* zp = P1 + (size_t)(seg_row0 + tc) * OINP + 2080 + ch0; zz[tap][0] = *(const u32x4*)zp; zz[tap][1] = *(const u32x4*)(zp + 8); }
#pragma unroll
      for (int tap = 0; tap < 4; ++tap) { const int t = ts + i + tap - 1; const float ok = (t >= 0 && t < seglen) ? 1.f : 0.f; const float* wt = SM + SM_CW + tap * 512 + ch0; const u32x4 z0 = zz[tap][0], z1 = zz[tap][1];
#pragma unroll
          for (int j = 0; j < 4; ++j) { acc[2 * j] += bflo(z0[j]) * (wt[2 * j] * ok); acc[2 * j + 1] += bfhi(z0[j]) * (wt[2 * j + 1] * ok); acc[8 + 2 * j] += bflo(z1[j]) * (wt[8 + 2 * j] * ok); acc[8 + 2 * j + 1] += bfhi(z1[j]) * (wt[8 + 2 * j + 1] * ok); } }
      const int rowi = (c0 >> 6) * 64 + i, cc = c0 & 63; u32x4 x0, x1;
#pragma unroll
      for (int j = 0; j < 16; ++j) XR[rowi * 65 + cc + j] = acc[j];
#pragma unroll
      for (int j = 0; j < 4; ++j) { x0[j] = pk2(acc[2 * j], acc[2 * j + 1]); x1[j] = pk2(acc[8 + 2 * j], acc[8 + 2 * j + 1]); }
      *(LAS u32x4*)(XB + rowi * 72 + cc) = x0; *(LAS u32x4*)(XB + rowi * 72 + cc + 8) = x1; }
    __syncthreads();
    float av[32], uv[32];
    { const float sp = log1p_small(__expf(-lamv));
#pragma unroll
      for (int mt = 0; mt < 2; ++mt) { f32x16 ca = zero16(), cx = zero16();
#pragma unroll
          for (int ks = 0; ks < 4; ++ks) { const bf16x8 af = *(const LAS bf16x8*)(XB + (nbl * 64 + 32 * mt + l31) * 72 + 16 * ks + 8 * h); ca = MFMA32(af, wa[ks], ca); cx = MFMA32(af, wx[ks], cx); }
#pragma unroll
          for (int r = 0; r < 16; ++r) { const int i = 32 * mt + crow(r, h);
              const float rr = sigmoidf_(ca[r] + ba), ii = sigmoidf_(cx[r] + bx), la = -8.0f * rr * sp;
              const float aa = __expf(la); av[mt * 16 + r] = aa; uv[mt * 16 + r] = __builtin_amdgcn_sqrtf((1.0f - aa) * (1.0f + aa)) * (ii * XR[(nbl * 64 + i) * 65 + d]); } } }
    float ptot, hend;
    if (dir == 0) lru_scan_regs<0, FINAL>(av, uv, h_in, h, lane, ptot, hend); else lru_scan_regs<1, FINAL>(av, uv, h_in, h, lane, ptot, hend);
    if (!FINAL) { if (h == 0) { float* o = (float*)(p.ws + WS_LRUP) + cidx * 2; o[0] = ptot; o[1] = hend; } }
    else {
#pragma unroll
        for (int mt = 0; mt < 2; ++mt)
#pragma unroll
            for (int r = 0; r < 16; ++r) HS[((dir * 2 + nbl) * 64 + 32 * mt + crow(r, h)) * 65 + d] = uv[mt * 16 + r];
        __syncthreads();
        const int i = tid >> 3, c0 = (tid & 7) * 16, ch0 = nbp * 128 + c0, nl = c0 >> 6, cc = c0 & 63;
        const u32x4 z0 = zg0, z1 = zg1;
        u32x4 o0, o1;
#pragma unroll
        for (int j = 0; j < 4; ++j) { const LAS float* f0 = HS + ((0 * 2 + nl) * 64 + i) * 65 + cc; const LAS float* f1 = HS + ((1 * 2 + nl) * 64 + i) * 65 + cc;
            o0[j] = pk2((f0[2 * j] + f1[2 * j]) * gelu_tanh(bflo(z0[j])), (f0[2 * j + 1] + f1[2 * j + 1]) * gelu_tanh(bfhi(z0[j])));
            o1[j] = pk2((f0[8 + 2 * j] + f1[8 + 2 * j]) * gelu_tanh(bflo(z1[j])), (f0[8 + 2 * j + 1] + f1[8 + 2 * j + 1]) * gelu_tanh(bfhi(z1[j]))); }
        bf16_t* op = (bf16_t*)(p.ws + WS_MIX) + (size_t)(row0 + i) * DM + 512 + ch0; *(u32x4*)op = o0; *(u32x4*)(op + 8) = o1;
    }
    __syncthreads();
}
DI void lru_scan(const Params& p, int item, int wv_) {
    const int gi = item * NTHR + otid(), ch = gi & 511, bd = gi >> 9, dir = bd & 1;
    const float* ph = (const float*)(p.ws + WS_LRUP) + ((size_t)bd * NCH * 512 + ch) * 2; float* cr = (float*)(p.ws + WS_LRUC) + (size_t)bd * NCH * 512 + ch;
    float hh = 0.f;
    for (int s0 = 0; s0 < NCH; s0 += 12) { f32x2 v[12];
#pragma unroll
        for (int j = 0; j < 12; ++j) v[j] = *(const f32x2*)(ph + (size_t)scan_cid(dir, s0 + j) * 1024);
#pragma unroll
        for (int j = 0; j < 12; ++j) { cr[(size_t)scan_cid(dir, s0 + j) * 512] = hh; hh = v[j][0] * hh + v[j][1]; } }
}

#define XB_TMO      128
#define XB_XCNT(j)  (256  + 64 * (j))
#define XB_XSUB(j)  (1280 + 64 * (j))
#define XB_XGEN(j)  (2304 + 64 * (j))
#define XB_TOP      3328
#define XB_TOPGEN   3392
#define XCD_BAR_WORDS 3456
#define XB_SPIN_CAP (1u << 20)
DI unsigned xb_ld(unsigned* p)              { return __hip_atomic_load(p, __ATOMIC_RELAXED, __HIP_MEMORY_SCOPE_AGENT); }
DI unsigned xb_add(unsigned* p, unsigned v) { return __hip_atomic_fetch_add(p, v, __ATOMIC_RELAXED, __HIP_MEMORY_SCOPE_AGENT); }
DI unsigned xb_xcc_id() { return (unsigned)__builtin_amdgcn_s_getreg((3 << 11) | 20) & 0xFu; }
#define XB_SPIN(cond, bar) do { unsigned _sp = 0; while (cond) { __builtin_amdgcn_s_sleep(1); \
    if ((++_sp & 255u) == 0u) { if (xb_ld(&(bar)[XB_TMO])) break; if (_sp > XB_SPIN_CAP) { atomicAdd(&(bar)[XB_TMO], 1u); break; } } } } while (0)
struct XcdBarrier { unsigned* bar; unsigned x; volatile LAS unsigned* st; };
DI void xcd_barrier_complete(unsigned* bar, unsigned x, unsigned& nloc, unsigned& nx) {
    const unsigned G = gridDim.x * gridDim.y * gridDim.z;
    unsigned sum, cnt, mine, sp = 0u;
    for (;;) {
        sum = 0u; cnt = 0u; mine = 0u;
#pragma unroll
        for (unsigned j = 0; j < 16; ++j) { const unsigned c = xb_ld(&bar[XB_XCNT(j)]); sum += c; cnt += (c > 0u) ? 1u : 0u; mine = (j == x) ? c : mine; }
        if (sum == G) break;
        __builtin_amdgcn_s_sleep(1);
        if ((++sp & 255u) == 0u) { if (xb_ld(&bar[XB_TMO])) break; if (sp > XB_SPIN_CAP) { atomicAdd(&bar[XB_TMO], 1u); break; } }
    }
    nloc = mine > 0u ? mine : 1u; nx = cnt > 0u ? cnt : 1u;
}
DI void xcd_barrier(const XcdBarrier& b, int wv_) {
    asm volatile("s_waitcnt vmcnt(0)" ::: "memory");
    __syncthreads();
    if (otid() == 0) {
        unsigned* bar = b.bar;
        __builtin_amdgcn_s_waitcnt(0);
        unsigned nloc = b.st[0], nx = b.st[1];
        if (nloc == 0u) { xcd_barrier_complete(bar, b.x, nloc, nx); b.st[0] = nloc; b.st[1] = nx; }
        const unsigned old = xb_add(&bar[XB_XSUB(b.x)], 1u);
        const unsigned gen = old / nloc;
        if (old + 1u == (gen + 1u) * nloc) {
            __builtin_amdgcn_fence(__ATOMIC_RELEASE, "agent");
            asm volatile("s_waitcnt vmcnt(0)" ::: "memory");
            const unsigned og = xb_add(&bar[XB_TOP], 1u);
            const unsigned tg = og / nx;
            if (og + 1u == (tg + 1u) * nx) xb_add(&bar[XB_TOPGEN], 1u);
            else XB_SPIN(xb_ld(&bar[XB_TOPGEN]) == tg, bar);
            __builtin_amdgcn_fence(__ATOMIC_ACQUIRE, "agent");
            xb_add(&bar[XB_XGEN(b.x)], 1u);
            asm volatile("s_waitcnt vmcnt(0)" ::: "memory");
        } else {
            XB_SPIN(xb_ld(&bar[XB_XGEN(b.x)]) == gen, bar);
            __builtin_amdgcn_fence(__ATOMIC_ACQUIRE, "agent");
            asm volatile("s_waitcnt vmcnt(0)" ::: "memory");
        }
    }
    __syncthreads();
}

__global__ void __launch_bounds__(NTHR) fwd_megakernel(const Params p) {
    extern __shared__ __attribute__((aligned(16))) unsigned char lds_raw[];
    cg::grid_group grid = cg::this_grid();
    constexpr int XB_LDS_OFF = LDS_BYTES - 16;
    const int wv_ = __builtin_amdgcn_readfirstlane((int)threadIdx.x >> 6);
    { const int t0 = otid(); if (blockIdx.x == 0) { unsigned* bw = (unsigned*)(p.ws + WS_BAR); for (int i = t0; i < XCD_BAR_WORDS; i += NTHR) bw[i] = 0u; }
      if (t0 < 4) ((LAS unsigned*)((LAS unsigned char*)lds_raw + XB_LDS_OFF))[t0] = 0u; }
    __syncthreads();
    { int oz = 0; asm volatile("" : "+s"(oz)); Params q = p; q.ws = p.ws + oz; phase0((LAS unsigned char*)lds_raw + oz, q, (int)gridDim.x + oz, (int)blockIdx.x + oz, wv_); }
    grid.sync();
    if (otid() == 0) (void)xb_add(&((unsigned*)(p.ws + WS_BAR))[XB_XCNT(xb_xcc_id())], 1u);
#ifndef PROBE_MASK
#define PROBE_MASK 0u
#endif
    for (int ph = 0; ph < 17; ++ph) {
      for (int rep = 0; rep <= (int)((PROBE_MASK >> ph) & 1u); ++rep) {
        int oz = 0; asm volatile("" : "+s"(oz));
        Params q = p; q.ws = p.ws + oz; q.out = p.out + oz;
        const Params& p = q;
        LAS unsigned char* lds = (LAS unsigned char*)lds_raw + oz;
        const int G = (int)gridDim.x + oz, bid = (int)blockIdx.x + oz;
        unsigned char* ws = p.ws;
        bf16_t* H = (bf16_t*)(ws + WS_H); bf16_t* PB = (bf16_t*)(ws + WS_P); bf16_t* MIX = (bf16_t*)(ws + WS_MIX);
        bf16_t* XB = (bf16_t*)(ws + WS_X);
        const float* MOD = (const float*)(ws + WS_MOD); const float* ROPE = (const float*)(ws + WS_ROPE);
        const int li = ph < 7 ? 0 : 1;
        const float* mod = MOD + (size_t)li * 5 * 6144; const float* SMALLP = (const float*)(ws + WS_SMALL);
        if (ph == 0) norm_phase(G, bid, MT, p.in[0], p.in[2], XB, SMALLP + SM_NORMG, mod, 0, 1024, H, wv_);
        else if (ph == 4) norm_phase_x<0>(G, bid, MT, XB, SMALLP + SM_NORMG + 1024, mod, 3072, 4096, H, nullptr, wv_);
        else if (ph == 7) norm_phase_x<0>(G, bid, MT, XB, SMALLP + SM_NORMG + 2048, mod, 0, 1024, H, nullptr, wv_);
        else if (ph == 13) norm_phase_x<0>(G, bid, ML, XB, SMALLP + SM_NORMG + 3072, mod, 3072, 4096, H, nullptr, wv_);
        else if (ph == 1 || ph == 3 || ph == 5 || ph == 6 || ph == 8 || ph == 12 || ph == 14 || ph == 15) {
            pg8::Gemm g; pg8::Epi E; E.ws = ws; E.gate = mod;
            if (ph == 1) { g = pg8::Gemm{H, (const bf16_t*)(ws + WS_W_EIN), MT, EIN, DM}; E.mode = pg8::EPI_EVEN_IN; }
            else if (ph == 3) { g = pg8::Gemm{MIX, (const bf16_t*)(ws + WS_W_EOUT), MT, DM, DM}; E.mode = pg8::EPI_RESID; E.gate = mod + 2048; }
            else if (ph == 5) { g = pg8::Gemm{H, (const bf16_t*)(ws + WS_W_FIN), MT, 5632, DM}; E.mode = pg8::EPI_SWIGLU; }
            else if (ph == 6) { g = pg8::Gemm{PB, (const bf16_t*)(ws + WS_W_FOUT), MT, DM, DFF}; E.mode = pg8::EPI_RESID; E.gate = mod + 5120; }
            else if (ph == 8) { g = pg8::Gemm{H, (const bf16_t*)(ws + WS_W_OIN), MT, OINP, DM}; E.mode = pg8::EPI_ODD_IN; }
            else if (ph == 12) { g = pg8::Gemm{MIX, (const bf16_t*)(ws + WS_W_OOUT), ML, DM, DM}; E.mode = pg8::EPI_RESID; E.gate = mod + 2048; }
            else if (ph == 14) { g = pg8::Gemm{H, (const bf16_t*)(ws + WS_W_FIN) + (size_t)5632 * 1024, ML, 5632, DM}; E.mode = pg8::EPI_SWIGLU; }
            else { g = pg8::Gemm{PB, (const bf16_t*)(ws + WS_W_FOUT) + (size_t)1024 * DFF, ML, DM, DFF}; E.mode = pg8::EPI_RESID; E.gate = mod + 5120; }
            pg8::StaticOrder S; S.init(g.M, g.N, G, bid);
            if (ph == 3 || ph == 6) { S.init(ML, g.N, G, bid); S.nhalf = 32; }
            pg8::gemm_phase(lds, g, S, E, wv_);
            if (ph == 1 || ph == 3 || ph == 6) {
                const int ntile = (g.M / 256) * (g.N / 256), full = ph == 1 ? ntile % G : 32;
                if (full != 0 && bid >= full && G > full) prep_slack(lds, ws, ph, bid - full, G - full, wv_); }
        }
        else if (ph == 2) attn_phase(lds, p, G, bid, wv_);
        else if (ph == 9) { for (int it = bid; it < 528 + 2112; it += G) { if (it < 528) gla_pass1(lds, p, it, wv_); else { lru_pass<false>(lds, p, it - 528, wv_);
#ifdef PROBE_LRU2
 lru_pass<false>(lds, p, it - 528, wv_);
#endif
 } } }
        else if (ph == 10) { for (int it = bid; it < 264; it += G) { if (it < 256) gla_scan(p, it, wv_); else lru_scan(p, it - 256, wv_); } }
        else if (ph == 11) { for (int it = bid; it < 512 + 2048; it += G) { if (it < 512) gla_pass3(lds, p, it, wv_);
                else { const int j = it - 512, nbp = j & 3, bc = j >> 2, lc = bc & 127, b = bc >> 7; lru_pass<true>(lds, p, ((b * NCH) + lc + 4) * 4 + nbp, wv_);
#ifdef PROBE_LRU2
 lru_pass<true>(lds, p, ((b * NCH) + lc + 4) * 4 + nbp, wv_);
#endif
 } } }
        else if (ph == 16) norm_phase_x<1>(G, bid, ML, XB, SMALLP + SM_FG, nullptr, 0, 0, nullptr, p.out, wv_);
        if (ph < 16) { XcdBarrier xb; xb.bar = (unsigned*)(ws + WS_BAR); xb.x = xb_xcc_id(); xb.st = (volatile LAS unsigned*)(lds + XB_LDS_OFF); xcd_barrier(xb, wv_); }
      }
    }
}

extern "C" void kernel_launch(void* const* d_in, const int* in_sizes, int n_in, void* d_out, int out_size, void* d_ws, size_t ws_size, hipStream_t stream) {
    static int grid_blocks = 0;
    if (grid_blocks == 0) {
        if (n_in != 26 || ws_size < WS_END) { fprintf(stderr, "kernel_launch: unexpected inputs (n_in %d, ws %zu, need %zu)\n", n_in, ws_size, (size_t)WS_END); grid_blocks = -1; return; }
        int dev = 0, cus = 0, per_cu = 0;
        hipGetDevice(&dev);
        hipDeviceGetAttribute(&cus, hipDeviceAttributeMultiprocessorCount, dev);
        if (hipFuncSetAttribute((const void*)fwd_megakernel, hipFuncAttributeMaxDynamicSharedMemorySize, LDS_BYTES) != hipSuccess) fprintf(stderr, "kernel_launch: hipFuncSetAttribute failed\n");
        hipOccupancyMaxActiveBlocksPerMultiprocessor(&per_cu, (const void*)fwd_megakernel, NTHR, LDS_BYTES);
        if (per_cu < 1) { fprintf(stderr, "kernel_launch: occupancy query says %d blocks per CU\n", per_cu); per_cu = 1; }
        (void)hipGetLastError();
        grid_blocks = cus;
    }
    if (grid_blocks < 0) return;
    Params p{};
    for (int i = 0; i < 26; ++i) p.in[i] = (const float*)d_in[i];
    p.out = (float*)d_out; p.ws = (unsigned char*)d_ws;
    void* args[] = {&p};
    hipError_t e = hipLaunchCooperativeKernel((const void*)fwd_megakernel, dim3(grid_blocks), dim3(NTHR), args, LDS_BYTES, stream);
    if (e != hipSuccess) fprintf(stderr, "cooperative launch failed: %s (grid %d)\n", hipGetErrorString(e), grid_blocks);
}
```

```cpp
#include <hip/hip_runtime.h>
#include <hip/hip_cooperative_groups.h>
#include <cstdio>
namespace cg = cooperative_groups;

#define DI __device__ __forceinline__
#define LAS __attribute__((address_space(3)))
typedef unsigned short bf16_t;
typedef short bf16x8 __attribute__((ext_vector_type(8)));
typedef short s16x4 __attribute__((ext_vector_type(4)));
typedef float f32x2 __attribute__((ext_vector_type(2)));
typedef float f32x4 __attribute__((ext_vector_type(4)));
typedef float f32x16 __attribute__((ext_vector_type(16)));
typedef unsigned u32x2 __attribute__((ext_vector_type(2)));
typedef unsigned u32x4 __attribute__((ext_vector_type(4)));
typedef __bf16 bf16x2_t __attribute__((ext_vector_type(2)));

constexpr int NB = 4, LQ = 8192, LC = 256, DM = 1024;
constexpr int ML = NB * LQ, MC = NB * LC, MT = ML + MC;
constexpr int EIN = 2304, OINP = 2816, DFF = 2816;
constexpr int NCH = 132;
constexpr int NTHR = 512;
constexpr int LDS_BYTES = 147456;
constexpr float LOG2E = 1.4426950408889634f;

constexpr size_t al256(size_t x) { return (x + 255) & ~(size_t)255; }
constexpr size_t WS_H = 0;
constexpr size_t WS_P = al256(WS_H + (size_t)MT * DM * 2);
constexpr size_t WS_MIX = al256(WS_P + (size_t)MT * 2816 * 2);
constexpr size_t WS_XC = al256(WS_MIX + (size_t)MT * DM * 2);
constexpr size_t WS_W_EIN = al256(WS_XC + (size_t)MC * DM * 4);
constexpr size_t WS_W_EOUT = al256(WS_W_EIN + (size_t)EIN * DM * 2);
constexpr size_t WS_W_OIN = al256(WS_W_EOUT + (size_t)DM * DM * 2);
constexpr size_t WS_W_OOUT = al256(WS_W_OIN + (size_t)OINP * DM * 2);
constexpr size_t WS_W_FIN = al256(WS_W_OOUT + (size_t)DM * DM * 2);
constexpr size_t WS_W_FOUT = al256(WS_W_FIN + (size_t)2 * 5632 * DM * 2);
constexpr size_t WS_MOD = al256(WS_W_FOUT + (size_t)2 * DM * DFF * 2);
constexpr size_t WS_ROPE = al256(WS_MOD + (size_t)2 * 5 * 6144 * 4);
constexpr size_t WS_WGT = al256(WS_ROPE + (size_t)128 * 16 * 2 * 4);
constexpr size_t WS_SCAL = al256(WS_WGT + (size_t)2 * 2 * 8 * 64 * 64 * 2);
constexpr size_t WS_GDEC = al256(WS_SCAL + 256);
constexpr size_t WS_LRUP = al256(WS_GDEC + (size_t)32 * NCH * 64 * 4);
constexpr size_t WS_LRUC = al256(WS_LRUP + (size_t)8 * NCH * 512 * 2 * 4);
constexpr size_t WS_SMALL = al256(WS_LRUC + (size_t)8 * NCH * 512 * 4);
constexpr int SM_NORMG = 0, SM_SINK = 4096, SM_GGW = 4160, SM_GGB = 12352, SM_GNG = 12864, SM_CW = 12992, SM_CB = 15040, SM_BA = 15552, SM_BX = 16576, SM_LAM = 17600, SM_FG = 18624, SM_TOTAL = 19648;
constexpr size_t WS_QT = al256(WS_SMALL + (size_t)SM_TOTAL * 4);
constexpr size_t WS_KT = al256(WS_QT + (size_t)MT * 512 * 2);
constexpr size_t WS_X = al256(WS_KT + (size_t)MT * 512 * 2);
constexpr size_t WS_BAR = al256(WS_X + (size_t)MT * DM * 2);
constexpr size_t WS_PTRS = al256(WS_BAR + 3456 * 4);
constexpr size_t WS_END = al256(WS_PTRS + 256);

struct Params { const float* in[26]; float* out; unsigned char* ws; };

DI unsigned pk2(float lo, float hi) { f32x2 v = {lo, hi}; return __builtin_bit_cast(unsigned, __builtin_convertvector(v, bf16x2_t)); }
DI bf16_t f2bf(float x) { return (bf16_t)(pk2(x, 0.f) & 0xffffu); }
DI float bflo(unsigned u) { return __uint_as_float(u << 16); }
DI float bfhi(unsigned u) { return __uint_as_float(u & 0xffff0000u); }
DI float bf2f(bf16_t h) { return __uint_as_float((unsigned)h << 16); }
DI int otid_(int wv) { unsigned z = 0u; asm volatile("" : "+v"(z)); return (wv << 6) | (int)__builtin_amdgcn_mbcnt_hi(~0u, __builtin_amdgcn_mbcnt_lo(~0u, z)); }
#define otid() otid_(wv_)
DI float shx(float v, int mask, int lane) { return __int_as_float(__builtin_amdgcn_ds_bpermute((lane ^ mask) << 2, __float_as_int(v))); }
DI int crow(int reg, int h) { return (reg & 3) + 8 * (reg >> 2) + 4 * h; }
DI float sigmoidf_(float x) { return __builtin_amdgcn_rcpf(1.0f + __expf(-x)); }
DI float siluf_(float x) { return x * __builtin_amdgcn_rcpf(1.0f + __expf(-x)); }
DI float gelu_tanh(float x) { const float u = 0.7978845608028654f * (x + 0.044715f * x * x * x); const float t = 1.0f - 2.0f * __builtin_amdgcn_rcpf(1.0f + __expf(2.0f * u)); return 0.5f * x * (1.0f + t); }
DI float log1p_small(float e) { return e < 0.01f ? e * (1.0f - e * (0.5f - e * 0.33333333f)) : __logf(1.0f + e); }
DI float log_sigmoidf_(float x) { return fminf(x, 0.f) - log1p_small(__expf(-fabsf(x))); }
DI float neg_expm1(float x) { return x > -0.01f ? -x * (1.0f + x * (0.5f + x * 0.16666667f)) : 1.0f - __expf(x); }
#define MFMA32(a, b, c) __builtin_amdgcn_mfma_f32_32x32x16_bf16((a), (b), (c), 0, 0, 0)
DI f32x16 zero16() { f32x16 z; for (int i = 0; i < 16; ++i) z[i] = 0.f; return z; }
DI bf16x8 pack8(const f32x16& x, int s) {
    u32x4 p; p[0] = pk2(x[8 * s], x[8 * s + 1]); p[1] = pk2(x[8 * s + 2], x[8 * s + 3]); p[2] = pk2(x[8 * s + 4], x[8 * s + 5]); p[3] = pk2(x[8 * s + 6], x[8 * s + 7]);
    return __builtin_bit_cast(bf16x8, p);
}
DI bf16x8 tr_frag(LAS unsigned char* img, int pitch, int ka, int kb, int col0, int lane) {
    const int q_ = (lane & 15) >> 2, p_ = lane & 3;
    const s16x4 lo = __builtin_amdgcn_ds_read_tr16_b64_v4i16((LAS s16x4*)(img + (ka + q_) * pitch + (col0 + 4 * p_) * 2));
    const s16x4 hi = __builtin_amdgcn_ds_read_tr16_b64_v4i16((LAS s16x4*)(img + (kb + q_) * pitch + (col0 + 4 * p_) * 2));
    return __builtin_shufflevector(lo, hi, 0, 1, 2, 3, 4, 5, 6, 7);
}
DI int chunk_row0(int b, int cid) { return cid < 4 ? ML + b * LC + cid * 64 : b * LQ + (cid - 4) * 64; }

DI void tr_tile(LAS unsigned char* lds, const float* __restrict__ src, int ldsrc, int scol0, bool valid, int k0, bf16_t* __restrict__ dst, int lddst, int n0, float scale, int wv_) {
    LAS bf16_t* T = (LAS bf16_t*)lds;
    const int tid = otid(), nn = tid & 63, kq = tid >> 6;
#pragma unroll
    for (int it = 0; it < 8; ++it) { const int kk = kq + 8 * it; const float v = valid ? src[(size_t)(k0 + kk) * ldsrc + scol0 + nn] * scale : 0.f; T[nn * 72 + kk] = f2bf(v); }
    __syncthreads();
    const int n = tid >> 3, ks = (tid & 7) * 8;
    const u32x4 w = *(LAS u32x4*)(T + n * 72 + ks);
    *(u32x4*)(dst + (size_t)(n0 + n) * lddst + k0 + ks) = w;
    __syncthreads();
}
DI void tr_tile4(LAS unsigned char* lds, const float* __restrict__ src, int ldsrc, int scol0, bool valid, int k0, bf16_t* __restrict__ dst, int lddst, int n0, int wv_) {
    LAS bf16_t* T = (LAS bf16_t*)lds;
    const int tid = otid(), nn = tid & 63, kq = tid >> 6;
    float v[32];
#pragma unroll
    for (int it = 0; it < 32; ++it) v[it] = valid ? src[(size_t)(k0 + kq + 8 * it) * ldsrc + scol0 + nn] : 0.f;
#pragma unroll
    for (int it = 0; it < 32; ++it) T[nn * 264 + kq + 8 * it] = f2bf(v[it]);
    __syncthreads();
    const int n = tid >> 3, ks = (tid & 7) * 32;
#pragma unroll
    for (int j = 0; j < 4; ++j) { const u32x4 w = *(LAS u32x4*)(T + n * 264 + ks + 8 * j); *(u32x4*)(dst + (size_t)(n0 + n) * lddst + k0 + ks + 8 * j) = w; }
    __syncthreads();
}
DI void tr_item(LAS unsigned char* lds, int item, const float* src, int K, int Nsrc, bf16_t* dst, int mode, int wv_) {
    const int nkt = K / 256; const int nt = item / nkt, kt = item % nkt; const int n0 = nt * 64;
    int scol0 = n0; bool valid = n0 < Nsrc;
    if (mode == 1) { scol0 = ((n0 & 255) >> 7) * DFF + 128 * (n0 >> 8) + (n0 & 127); valid = true; }
    tr_tile4(lds, src, Nsrc, scol0, valid, kt * 256, dst, K, n0, wv_);
}
DI void adaln_item(LAS unsigned char* lds, const float* __restrict__ cin, const float* __restrict__ cctx, const float* __restrict__ adaw, const float* __restrict__ adab, unsigned char* ws, int li, int cgp, int wv_) {
    LAS float* SC = (LAS float*)lds;
    LAS float* RED = SC + 5120;
    const int tid = otid();
    for (int idx = tid; idx < 5120; idx += NTHR) { const int s = idx >> 10, k = idx & 1023; const float c = s < 4 ? cin[s * 1024 + k] : cctx[k]; SC[idx] = siluf_(c); }
    __syncthreads();
    const int col = cgp * 64 + (tid & 63), kg = tid >> 6;
    float a0 = 0.f, a1 = 0.f, a2 = 0.f, a3 = 0.f, a4 = 0.f;
    const float* w = adaw + ((size_t)li * 1024 + kg * 128) * 6144 + col;
#pragma unroll 8
    for (int kk = 0; kk < 128; ++kk) { const float wv = w[(size_t)kk * 6144]; const int k = kg * 128 + kk;
        a0 += SC[k] * wv; a1 += SC[1024 + k] * wv; a2 += SC[2048 + k] * wv; a3 += SC[3072 + k] * wv; a4 += SC[4096 + k] * wv; }
    RED[(kg * 5 + 0) * 64 + (tid & 63)] = a0; RED[(kg * 5 + 1) * 64 + (tid & 63)] = a1; RED[(kg * 5 + 2) * 64 + (tid & 63)] = a2;
    RED[(kg * 5 + 3) * 64 + (tid & 63)] = a3; RED[(kg * 5 + 4) * 64 + (tid & 63)] = a4;
    __syncthreads();
    if (tid < 320) { const int s = tid >> 6, c = tid & 63; float acc = 0.f;
#pragma unroll
        for (int g = 0; g < 8; ++g) acc += RED[(g * 5 + s) * 64 + c];
        float* MOD = (float*)(ws + WS_MOD);
        MOD[(size_t)(li * 5 + s) * 6144 + cgp * 64 + c] = acc + adab[li * 6144 + cgp * 64 + c]; }
    __syncthreads();
}
DI void tables_item(const Params& p, int wv_) {
    const int tid = otid();
    float* tab = (float*)(p.ws + WS_ROPE);
    for (int idx = tid; idx < 2048; idx += NTHR) {
        const int pos = idx >> 4, i = idx & 15;
        const double b4 = (i & 3) == 0 ? 1.0 : ((i & 3) == 1 ? 0.5623413251903491 : ((i & 3) == 2 ? 0.31622776601683794 : 0.1778279410038923));
        const double p10 = (i >> 2) == 0 ? 1.0 : ((i >> 2) == 1 ? 0.1 : ((i >> 2) == 2 ? 0.01 : 0.001));
        const float inv = (float)(b4 * p10);
        const float angf = (float)pos * inv;
        const double ang = (double)angf;
        const double kd = __builtin_rint(ang * 0.6366197723675814);
        const double r = ang - kd * 1.5707963267948966, r2 = r * r;
        const double sr = r * (1.0 - r2 / 6.0 * (1.0 - r2 / 20.0 * (1.0 - r2 / 42.0 * (1.0 - r2 / 72.0 * (1.0 - r2 / 110.0 * (1.0 - r2 / 156.0))))));
        const double cr = 1.0 - r2 / 2.0 * (1.0 - r2 / 12.0 * (1.0 - r2 / 30.0 * (1.0 - r2 / 56.0 * (1.0 - r2 / 90.0 * (1.0 - r2 / 132.0)))));
        const int kq = ((int)kd) & 3;
        const double cs = kq == 0 ? cr : (kq == 1 ? -sr : (kq == 2 ? -cr : sr));
        const double sn = kq == 0 ? sr : (kq == 1 ? cr : (kq == 2 ? -sr : -cr));
        tab[idx * 2] = (float)cs; tab[idx * 2 + 1] = (float)sn;
    }
    { float* SM = (float*)(p.ws + WS_SMALL);
      for (int i = tid; i < 4096; i += NTHR) SM[SM_NORMG + i] = p.in[6][i];
      for (int i = tid; i < 8; i += NTHR) SM[SM_SINK + i] = p.in[10][i];
      for (int i = tid; i < 8192; i += NTHR) SM[SM_GGW + i] = p.in[13][i];
      for (int i = tid; i < 512; i += NTHR) SM[SM_GGB + i] = p.in[14][i];
      for (int i = tid; i < 128; i += NTHR) SM[SM_GNG + i] = p.in[15][i];
      for (int i = tid; i < 2048; i += NTHR) SM[SM_CW + i] = p.in[16][i];
      for (int i = tid; i < 512; i += NTHR) SM[SM_CB + i] = p.in[17][i];
      for (int i = tid; i < 1024; i += NTHR) SM[SM_BA + i] = p.in[19][i] * -LOG2E;
      for (int i = tid; i < 1024; i += NTHR) SM[SM_BX + i] = p.in[21][i] * -LOG2E;
      for (int i = tid; i < 1024; i += NTHR) SM[SM_LAM + i] = p.in[22][i];
      for (int i = tid; i < 1024; i += NTHR) SM[SM_FG + i] = p.in[25][i]; }
    if (tid == 0) { const float** tab = (const float**)(p.ws + WS_PTRS);
#pragma unroll
        for (int i = 0; i < 26; ++i) tab[i] = p.in[i]; }
    if (tid == 0) { const float* lv = p.in[9]; float s1 = 0.f, s2 = 0.f;
        for (int i = 0; i < 64; ++i) { s1 += lv[i] * lv[64 + i]; s2 += lv[128 + i] * lv[192 + i]; }
        ((float*)(p.ws + WS_SCAL))[0] = expf(s1) - expf(s2) + 0.2f; }
}
constexpr int PC0 = 144, PC1 = PC0 + 64, PC2 = PC1 + 176, PC3 = PC2 + 64, PC4 = PC3 + 352, PC5 = PC4 + 352, PC6 = PC5 + 176, PC7 = PC6 + 176, PC8 = PC7 + 32, PC9 = PC8 + 192, PC10 = PC9 + 1;
#define PREP_ONE_BODY(IN, WS) \
    if (it < PC0) tr_item(lds, it, IN(7), 1024, EIN, (bf16_t*)((WS) + WS_W_EIN), 0, wv_); \
    else if (it < PC1) tr_item(lds, it - PC0, IN(8), 1024, 1024, (bf16_t*)((WS) + WS_W_EOUT), 0, wv_); \
    else if (it < PC2) tr_item(lds, it - PC1, IN(11), 1024, 2592, (bf16_t*)((WS) + WS_W_OIN), 0, wv_); \
    else if (it < PC3) tr_item(lds, it - PC2, IN(12), 1024, 1024, (bf16_t*)((WS) + WS_W_OOUT), 0, wv_); \
    else if (it < PC4) tr_item(lds, it - PC3, IN(23), 1024, 5632, (bf16_t*)((WS) + WS_W_FIN), 1, wv_); \
    else if (it < PC5) tr_item(lds, it - PC4, IN(23) + (size_t)1024 * 5632, 1024, 5632, (bf16_t*)((WS) + WS_W_FIN) + (size_t)5632 * 1024, 1, wv_); \
    else if (it < PC6) tr_item(lds, it - PC5, IN(24), DFF, 1024, (bf16_t*)((WS) + WS_W_FOUT), 0, wv_); \
    else if (it < PC7) tr_item(lds, it - PC6, IN(24) + (size_t)DFF * 1024, DFF, 1024, (bf16_t*)((WS) + WS_W_FOUT) + (size_t)1024 * DFF, 0, wv_); \
    else if (it < PC8) { const int j = it - PC7; const int dir = j >> 4, gate = (j >> 3) & 1, n = j & 7; \
        const float* src = (gate ? IN(20) : IN(18)) + (size_t)(dir * 8 + n) * 4096; \
        tr_tile(lds, src, 64, 0, true, 0, (bf16_t*)((WS) + WS_WGT) + (size_t)((dir * 2 + gate) * 8 + n) * 4096, 64, 0, -LOG2E, wv_); } \
    else if (it < PC9) { const int j = it - PC8; adaln_item(lds, IN(1), IN(3), IN(4), IN(5), (WS), j / 96, j % 96, wv_); }
DI void prep_one(LAS unsigned char* lds, const Params& p, int it, int wv_) {
#define PIN_(i) p.in[i]
    PREP_ONE_BODY(PIN_, p.ws)
    else tables_item(p, wv_);
#undef PIN_
}
DI void prep_one_tab(LAS unsigned char* lds, unsigned char* ws, int it, int wv_) {
    const float* const* tab = (const float* const*)(ws + WS_PTRS);
#define PIN_(i) tab[i]
    PREP_ONE_BODY(PIN_, ws)
#undef PIN_
}
DI void phase0(LAS unsigned char* lds, const Params& p, int G, int bid, int wv_) {
    for (int k = bid; k < 241; k += G) prep_one(lds, p, k < 144 ? k : (k < 240 ? PC8 + (k - 144) : PC9), wv_);
}
DI void prep_slack(LAS unsigned char* lds, unsigned char* ws, int which, int idle_rank, int n_idle, int wv_) {
    const int n = which == 1 ? 64 : (which == 3 ? 528 : 896);
    for (int k = idle_rank; k < n; k += n_idle) {
        int it;
        if (which == 1) it = PC0 + k;
        else if (which == 3) it = k < 352 ? PC3 + k : PC5 + (k - 352);
        else it = k < 240 ? PC1 + k : (k < 592 ? PC4 + (k - 240) : (k < 800 ? PC6 + (k - 592) : PC8 + 96 + (k - 800)));
        prep_one_tab(lds, ws, it, wv_);
    }
}

DI float wave_sum(float v, int lane) {
#pragma unroll
    for (int off = 32; off >= 1; off >>= 1) v += shx(v, off, lane);
    return v;
}
DI void norm_phase(int G, int bid, int nrows, const float* __restrict__ xl, const float* __restrict__ xc, bf16_t* __restrict__ X, const float* __restrict__ g,
                   const float* __restrict__ mod, int sh_off, int sc_off, bf16_t* __restrict__ H, int wv_) {
    const int tid_ = otid(), lane = tid_ & 63, wave = __builtin_amdgcn_readfirstlane(tid_ >> 6);
    const int stride = G * 8;
    for (int r0 = bid * 8 + wave; r0 < nrows; r0 += 2 * stride) {
        const int r1 = r0 + stride; const bool has1 = r1 < nrows; const int r1c = has1 ? r1 : r0;
        const float* s0 = r0 < ML ? xl + (size_t)r0 * DM : xc + (size_t)(r0 - ML) * DM;
        const float* s1 = r1c < ML ? xl + (size_t)r1c * DM : xc + (size_t)(r1c - ML) * DM;
        f32x4 v0[4], v1[4]; float ss0 = 0.f, ss1 = 0.f;
#pragma unroll
        for (int j = 0; j < 4; ++j) { v0[j] = *(const f32x4*)(s0 + j * 256 + lane * 4); v1[j] = *(const f32x4*)(s1 + j * 256 + lane * 4); }
#pragma unroll
        for (int j = 0; j < 4; ++j) { ss0 += v0[j][0] * v0[j][0] + v0[j][1] * v0[j][1] + v0[j][2] * v0[j][2] + v0[j][3] * v0[j][3];
                                      ss1 += v1[j][0] * v1[j][0] + v1[j][1] * v1[j][1] + v1[j][2] * v1[j][2] + v1[j][3] * v1[j][3]; }
#pragma unroll
        for (int off = 32; off >= 1; off >>= 1) { ss0 += shx(ss0, off, lane); ss1 += shx(ss1, off, lane); }
        const float rstd0 = rsqrtf(ss0 * (1.0f / 1024.0f) + 1e-6f), rstd1 = rsqrtf(ss1 * (1.0f / 1024.0f) + 1e-6f);
        const float* m0 = mod + (size_t)(r0 < ML ? (r0 >> 13) : 4) * 6144; const float* m1 = mod + (size_t)(r1c < ML ? (r1c >> 13) : 4) * 6144;
#pragma unroll
        for (int j = 0; j < 4; ++j) { const int col = j * 256 + lane * 4; const f32x4 gg = *(const f32x4*)(g + col);
            const f32x4 h0 = v0[j] * rstd0 * gg * (*(const f32x4*)(m0 + sc_off + col) + 1.0f) + *(const f32x4*)(m0 + sh_off + col);
            const f32x4 h1 = v1[j] * rstd1 * gg * (*(const f32x4*)(m1 + sc_off + col) + 1.0f) + *(const f32x4*)(m1 + sh_off + col);
            u32x2 w0, w1, x0, x1; w0[0] = pk2(h0[0], h0[1]); w0[1] = pk2(h0[2], h0[3]); w1[0] = pk2(h1[0], h1[1]); w1[1] = pk2(h1[2], h1[3]);
            x0[0] = pk2(v0[j][0], v0[j][1]); x0[1] = pk2(v0[j][2], v0[j][3]); x1[0] = pk2(v1[j][0], v1[j][1]); x1[1] = pk2(v1[j][2], v1[j][3]);
            *(u32x2*)(H + (size_t)r0 * DM + col) = w0; *(u32x2*)(X + (size_t)r0 * DM + col) = x0;
            if (has1) { *(u32x2*)(H + (size_t)r1 * DM + col) = w1; *(u32x2*)(X + (size_t)r1 * DM + col) = x1; } }
    }
}
DI void unpack16(const u32x4& a, const u32x4& b, float (&f)[16]) {
#pragma unroll
    for (int j = 0; j < 4; ++j) { f[2 * j] = bflo(a[j]); f[2 * j + 1] = bfhi(a[j]); f[8 + 2 * j] = bflo(b[j]); f[8 + 2 * j + 1] = bfhi(b[j]); }
}
template <int MODE>
DI void norm_phase_x(int G, int bid, int nrows, const bf16_t* __restrict__ X, const float* __restrict__ g, const float* __restrict__ mod, int sh_off, int sc_off, bf16_t* __restrict__ H, float* __restrict__ out, int wv_) {
    const int tid_ = otid(), lane = tid_ & 63, wave = __builtin_amdgcn_readfirstlane(tid_ >> 6);
    const int stride = G * 8, col = lane * 16;
    for (int r0 = bid * 8 + wave; r0 < nrows; r0 += 2 * stride) {
        const int r1 = r0 + stride; const bool has1 = r1 < nrows; const int r1c = has1 ? r1 : r0;
        const u32x4 a0 = *(const u32x4*)(X + (size_t)r0 * DM + col), b0 = *(const u32x4*)(X + (size_t)r0 * DM + col + 8);
        const u32x4 a1 = *(const u32x4*)(X + (size_t)r1c * DM + col), b1 = *(const u32x4*)(X + (size_t)r1c * DM + col + 8);
        float v0[16], v1[16]; unpack16(a0, b0, v0); unpack16(a1, b1, v1);
        float ss0 = 0.f, ss1 = 0.f;
#pragma unroll
        for (int j = 0; j < 16; ++j) { ss0 += v0[j] * v0[j]; ss1 += v1[j] * v1[j]; }
#pragma unroll
        for (int off = 32; off >= 1; off >>= 1) { ss0 += shx(ss0, off, lane); ss1 += shx(ss1, off, lane); }
        const float rstd0 = rsqrtf(ss0 * (1.0f / 1024.0f) + 1e-6f), rstd1 = rsqrtf(ss1 * (1.0f / 1024.0f) + 1e-6f);
        if (MODE == 0) {
            const float* m0 = mod + (size_t)(r0 < ML ? (r0 >> 13) : 4) * 6144; const float* m1 = mod + (size_t)(r1c < ML ? (r1c >> 13) : 4) * 6144;
            u32x4 w0[2], w1[2];
#pragma unroll
            for (int q = 0; q < 4; ++q) { const f32x4 gg = *(const f32x4*)(g + col + 4 * q);
                const f32x4 sc0 = *(const f32x4*)(m0 + sc_off + col + 4 * q), sh0 = *(const f32x4*)(m0 + sh_off + col + 4 * q), sc1 = *(const f32x4*)(m1 + sc_off + col + 4 * q), sh1 = *(const f32x4*)(m1 + sh_off + col + 4 * q);
                const f32x4 x0 = {v0[4 * q], v0[4 * q + 1], v0[4 * q + 2], v0[4 * q + 3]}, x1 = {v1[4 * q], v1[4 * q + 1], v1[4 * q + 2], v1[4 * q + 3]};
                const f32x4 h0 = x0 * rstd0 * gg * (sc0 + 1.0f) + sh0, h1 = x1 * rstd1 * gg * (sc1 + 1.0f) + sh1;
                w0[q >> 1][(q & 1) * 2] = pk2(h0[0], h0[1]); w0[q >> 1][(q & 1) * 2 + 1] = pk2(h0[2], h0[3]); w1[q >> 1][(q & 1) * 2] = pk2(h1[0], h1[1]); w1[q >> 1][(q & 1) * 2 + 1] = pk2(h1[2], h1[3]); }
            *(u32x4*)(H + (size_t)r0 * DM + col) = w0[0]; *(u32x4*)(H + (size_t)r0 * DM + col + 8) = w0[1];
            if (has1) { *(u32x4*)(H + (size_t)r1 * DM + col) = w1[0]; *(u32x4*)(H + (size_t)r1 * DM + col + 8) = w1[1]; }
        } else {
#pragma unroll
            for (int q = 0; q < 4; ++q) { const f32x4 gg = *(const f32x4*)(g + col + 4 * q);
                const f32x4 x0 = {v0[4 * q], v0[4 * q + 1], v0[4 * q + 2], v0[4 * q + 3]}, x1 = {v1[4 * q], v1[4 * q + 1], v1[4 * q + 2], v1[4 * q + 3]};
                *(f32x4*)(out + (size_t)r0 * DM + col + 4 * q) = x0 * rstd0 * gg; if (has1) *(f32x4*)(out + (size_t)r1 * DM + col + 4 * q) = x1 * rstd1 * gg; }
        }
    }
}

namespace pg8 {
constexpr int BM = 256, BK = 64, HALF = 128, HTB = HALF * BK * 2, STAGE_BYTES = 8 * HTB, NXCD = 8, WGM = 8;
DI int lds_byte(int r, int c) { const int st = (r >> 4) * 2 + (c >> 5), rr = r & 15, cc = c & 31, ob = rr * 64 + cc * 2; return st * 1024 + (ob ^ (((ob >> 9) & 1) << 5)); }
DI void stage_rc(int b, int& R, int& C) { const int st = b / 1024, sb = b % 1024, swz = sb ^ (((sb >> 9) & 1) << 5); R = (st >> 1) * 16 + swz / 64; C = (st & 1) * 32 + (swz % 64) / 2; }
DI int perm32(int rho) { const int n = rho >> 4, i = rho & 15; return 8 * (i >> 2) + 4 * n + (i & 3); }
struct Unit { int pm, pn; };
struct Gemm { const bf16_t* A; const bf16_t* Bt; int M, N, K; };
struct StaticOrder {
    int nM, nN, nwg, G, c;
    DI void init(int M, int N, int G_, int c_) { nM = M / BM; nN = N / BM; nwg = nM * nN; G = G_; c = c_; }
    DI bool next(int i, Unit& u) const {
        const long L = (long)i * G + c; if (L >= nwg) return false;
        int wgid = (int)L; { const int q = nwg / NXCD, r = nwg % NXCD, xcd = wgid % NXCD, off = wgid / NXCD; wgid = (xcd < r ? xcd * (q + 1) : r * (q + 1) + (xcd - r) * q) + off; }
        const int nig = WGM * nN, gid = wgid / nig, fm = gid * WGM, gsz = (nM - fm) < WGM ? (nM - fm) : WGM;
        u.pm = fm + ((wgid % nig) % gsz); u.pn = (wgid % nig) / gsz; return true;
    }
};
enum { EPI_EVEN_IN = 0, EPI_RESID = 1, EPI_SWIGLU = 2, EPI_ODD_IN = 3 };
struct Epi { int mode; bf16_t* O; bf16_t* xb; const float* gate; const float* rope; };

DI void epilogue(const f32x4 (&acc)[2][2][4][2], const Unit& u, int wr, int wc, int fr, int fq, const Epi& E) {
    if (E.mode == EPI_RESID) {
        bf16_t* X = E.xb + (size_t)u.pm * 256 * DM;
        const int s = u.pm < 128 ? (u.pm >> 5) : 4;
#pragma unroll
        for (int bj = 0; bj < 2; ++bj) { const int col0 = u.pn * BM + bj * HALF + wc * 32 + 8 * fq;
            const f32x4 gv0 = *(const f32x4*)(E.gate + (size_t)s * 6144 + col0), gv1 = *(const f32x4*)(E.gate + (size_t)s * 6144 + col0 + 4);
            u32x4 xin[2][4];
#pragma unroll
            for (int ai = 0; ai < 2; ++ai)
#pragma unroll
                for (int m = 0; m < 4; ++m) xin[ai][m] = *(const u32x4*)(X + (size_t)(ai * HALF + wr * 64 + m * 16 + fr) * DM + col0);
#pragma unroll
            for (int ai = 0; ai < 2; ++ai)
#pragma unroll
                for (int m = 0; m < 4; ++m) { const u32x4 xi = xin[ai][m]; const f32x4 a0 = acc[ai][bj][m][0], a1 = acc[ai][bj][m][1]; u32x4 w;
                    w[0] = pk2(bflo(xi[0]) + gv0[0] * a0[0], bfhi(xi[0]) + gv0[1] * a0[1]); w[1] = pk2(bflo(xi[1]) + gv0[2] * a0[2], bfhi(xi[1]) + gv0[3] * a0[3]);
                    w[2] = pk2(bflo(xi[2]) + gv1[0] * a1[0], bfhi(xi[2]) + gv1[1] * a1[1]); w[3] = pk2(bflo(xi[3]) + gv1[2] * a1[2], bfhi(xi[3]) + gv1[3] * a1[3]);
                    *(u32x4*)(X + (size_t)(ai * HALF + wr * 64 + m * 16 + fr) * DM + col0) = w; }
            asm volatile("" ::: "memory"); }
    } else if (E.mode == EPI_SWIGLU) {
        const int f0 = u.pn * 128 + wc * 32 + 8 * fq;
#pragma unroll
        for (int ai = 0; ai < 2; ++ai)
#pragma unroll
            for (int m = 0; m < 4; ++m) { const size_t row = (size_t)u.pm * BM + ai * HALF + wr * 64 + m * 16 + fr;
                const f32x4 g0 = acc[ai][0][m][0], g1 = acc[ai][0][m][1], u0 = acc[ai][1][m][0], u1 = acc[ai][1][m][1];
                u32x4 w; w[0] = pk2(siluf_(g0[0]) * u0[0], siluf_(g0[1]) * u0[1]); w[1] = pk2(siluf_(g0[2]) * u0[2], siluf_(g0[3]) * u0[3]);
                w[2] = pk2(siluf_(g1[0]) * u1[0], siluf_(g1[1]) * u1[1]); w[3] = pk2(siluf_(g1[2]) * u1[2], siluf_(g1[3]) * u1[3]);
                *(u32x4*)(E.O + row * DFF + f0) = w; }
    } else if (E.mode == EPI_ODD_IN) {
#pragma unroll
        for (int bj = 0; bj < 2; ++bj) { const int col0 = u.pn * BM + bj * HALF + wc * 32 + 8 * fq; const float sc = col0 < 256 ? 0.125f : 1.0f;
#pragma unroll
            for (int ai = 0; ai < 2; ++ai)
#pragma unroll
                for (int m = 0; m < 4; ++m) { const size_t row = (size_t)u.pm * BM + ai * HALF + wr * 64 + m * 16 + fr;
                    const f32x4 v0 = acc[ai][bj][m][0] * sc, v1 = acc[ai][bj][m][1] * sc;
                    u32x4 w; w[0] = pk2(v0[0], v0[1]); w[1] = pk2(v0[2], v0[3]); w[2] = pk2(v1[0], v1[1]); w[3] = pk2(v1[2], v1[3]);
                    if (col0 < 2592) *(u32x4*)(E.O + row * OINP + col0) = w; } }
    } else {
        const bool latent = u.pm < 128;
        const int half = wc & 1;
        f32x4 t0[2][4], t1[2][4];
#pragma unroll
        for (int ai = 0; ai < 2; ++ai)
#pragma unroll
            for (int m = 0; m < 4; ++m) { const int rl = ai * HALF + wr * 64 + m * 16 + fr; const int t = ((u.pm & 31) << 8) + rl; const int pos = half ? (t & 63) : (t >> 6);
                t0[ai][m] = *(const f32x4*)(E.rope + (pos * 16 + 4 * fq) * 2); t1[ai][m] = *(const f32x4*)(E.rope + (pos * 16 + 4 * fq) * 2 + 4); }
#pragma unroll
        for (int bj = 0; bj < 2; ++bj) { const int cb = u.pn * BM + bj * HALF + wc * 32;
            const bool roped = latent && (cb < 1024 || (cb >= 1536 && cb < 2176));
            const float qs = (cb < 512 || (cb >= 1536 && cb < 2048)) ? 0.125f * LOG2E : 1.0f;
#pragma unroll
            for (int ai = 0; ai < 2; ++ai)
#pragma unroll
                for (int m = 0; m < 4; ++m) { const int rl = ai * HALF + wr * 64 + m * 16 + fr; const size_t row = (size_t)u.pm * BM + rl;
                    f32x4 x1 = acc[ai][bj][m][0], x2 = acc[ai][bj][m][1];
                    if (roped) { const f32x4 a = t0[ai][m], c = t1[ai][m]; const f32x4 cs = {a[0], a[2], c[0], c[2]}, sn = {a[1], a[3], c[1], c[3]};
                        const f32x4 o1 = x1 * cs - x2 * sn, o2 = x1 * sn + x2 * cs; x1 = o1; x2 = o2; }
                    x1 *= qs; x2 *= qs;
                    u32x2 w1, w2; w1[0] = pk2(x1[0], x1[1]); w1[1] = pk2(x1[2], x1[3]); w2[0] = pk2(x2[0], x2[1]); w2[1] = pk2(x2[2], x2[3]);
                    *(u32x2*)(E.O + row * EIN + cb + 4 * fq) = w1; *(u32x2*)(E.O + row * EIN + cb + 16 + 4 * fq) = w2; } }
    }
}

DI void gemm_phase(LAS unsigned char* lds, const Gemm g, const StaticOrder& S, const Epi& E, int wv_) {
    const int tid = otid(), wid = __builtin_amdgcn_readfirstlane(tid >> 6), lane = tid & 63, wr = wid >> 2, wc = wid & 3, fr = lane & 15, fq = lane >> 4;
    const int K = g.K, nt = K / BK;
    const bool perm = (E.mode != EPI_EVEN_IN);
    unsigned voffA[2], voffB[2];
#pragma unroll
    for (int i = 0; i < 2; ++i) { int R, C; stage_rc(tid * 16 + i * 8192, R, C); const int Rb = perm ? ((R & ~31) + perm32(R & 31)) : R;
        voffA[i] = (unsigned)(R * K + C) * 2u; voffB[i] = (unsigned)(Rb * K + C) * 2u; }
    const size_t kstep = (size_t)(BK * 2);
    const size_t hstep = (size_t)HALF * K * 2;
    const size_t tstep = 2 * hstep;
    const unsigned ldsw = (unsigned)wid * 1024u;
    const int aoff = lds_byte(wr * 64 + fr, fq * 8), boff = lds_byte(wc * 32 + fr, fq * 8);
#define PG8_SA(b, h) (((b) * 2 + (h)) * HTB)
#define PG8_SB(b, h) ((4 + (b) * 2 + (h)) * HTB)
#define PG8_STAGE(bufoff, gbase, voff) do { _Pragma("unroll") for (int _i = 0; _i < 2; ++_i) \
        __builtin_amdgcn_global_load_lds((const unsigned*)((const char*)(gbase) + (voff)[_i]), (LAS unsigned*)(lds + (bufoff) + ldsw + _i * 8192), 16, 0, 0); } while (0)
#define PG8_LDA(dst, b, h) do { _Pragma("unroll") for (int m = 0; m < 4; ++m) _Pragma("unroll") for (int k = 0; k < 2; ++k) dst[m][k] = *(const LAS bf16x8*)(lds + PG8_SA(b, h) + aoff + m * 2048 + k * 1024); } while (0)
#define PG8_LDB(dst, b, h) do { _Pragma("unroll") for (int n = 0; n < 2; ++n) _Pragma("unroll") for (int k = 0; k < 2; ++k) dst[n][k] = *(const LAS bf16x8*)(lds + PG8_SB(b, h) + boff + n * 2048 + k * 1024); } while (0)
#define PG8_MMA(ai, bj, At, Bt) do { __builtin_amdgcn_s_setprio(1); _Pragma("unroll") for (int m = 0; m < 4; ++m) _Pragma("unroll") for (int n = 0; n < 2; ++n) _Pragma("unroll") for (int k = 0; k < 2; ++k) \
        acc[ai][bj][m][n] = __builtin_amdgcn_mfma_f32_16x16x32_bf16(Bt[n][k], At[m][k], acc[ai][bj][m][n], 0, 0, 0); __builtin_amdgcn_s_setprio(0); } while (0)
#define PG8_WAIT_V(n) asm volatile("s_waitcnt vmcnt(" #n ")" ::: "memory")
#define PG8_WAIT_L(n) asm volatile("s_waitcnt lgkmcnt(" #n ")" ::: "memory")
#define PG8_BAR __builtin_amdgcn_s_barrier()
#define PG8_SCHED __builtin_amdgcn_sched_barrier(0)
    Unit cur, nxt; int ui = 0;
    if (!S.next(0, cur)) return;
    f32x4 acc[2][2][4][2];
#pragma unroll
    for (int a = 0; a < 2; ++a)
#pragma unroll
        for (int b = 0; b < 2; ++b)
#pragma unroll
            for (int m = 0; m < 4; ++m)
#pragma unroll
                for (int n = 0; n < 2; ++n) acc[a][b][m][n] = (f32x4){0.f, 0.f, 0.f, 0.f};
    bf16x8 At[4][2], B0[2][2], B1[2][2];
    const char* cA = (const char*)g.A + (size_t)cur.pm * tstep; const char* cB = (const char*)g.Bt + (size_t)cur.pn * tstep;
    PG8_STAGE(PG8_SB(0, 0), cB, voffB); PG8_STAGE(PG8_SA(0, 0), cA, voffA); PG8_STAGE(PG8_SB(0, 1), cB + hstep, voffB); PG8_STAGE(PG8_SA(0, 1), cA + hstep, voffA);
    if (wr == 1) PG8_BAR;
    PG8_WAIT_V(4); PG8_BAR;
    PG8_STAGE(PG8_SB(1, 0), cB + kstep, voffB); PG8_STAGE(PG8_SA(1, 0), cA + kstep, voffA); PG8_STAGE(PG8_SB(1, 1), cB + hstep + kstep, voffB);
    PG8_WAIT_V(6); PG8_BAR;
    for (;;) {
        const bool has_next = S.next(ui + 1, nxt);
        const char* nA = has_next ? (const char*)g.A + (size_t)nxt.pm * tstep : cA; const char* nB = has_next ? (const char*)g.Bt + (size_t)nxt.pn * tstep : cB;
        for (int t = 0; t < nt; t += 2) {
            const bool last = (t == nt - 2);
            const char* a1 = cA + (size_t)(t + 1) * kstep;
            const char* a2 = last ? nA : cA + (size_t)(t + 2) * kstep; const char* b2 = last ? nB : cB + (size_t)(t + 2) * kstep;
            const char* a3 = a2 + kstep; const char* b3 = b2 + kstep;
            PG8_LDB(B0, 0, 0); PG8_SCHED; PG8_LDA(At, 0, 0); PG8_STAGE(PG8_SA(1, 1), a1 + hstep, voffA);
            PG8_WAIT_L(8); PG8_BAR; PG8_WAIT_L(0); PG8_MMA(0, 0, At, B0); PG8_BAR; PG8_SCHED;
            PG8_LDB(B1, 0, 1); PG8_STAGE(PG8_SB(0, 0), b2, voffB);
            PG8_BAR; PG8_WAIT_L(0); PG8_MMA(0, 1, At, B1); PG8_BAR;
            PG8_LDA(At, 0, 1); PG8_STAGE(PG8_SA(0, 0), a2, voffA);
            PG8_BAR; PG8_WAIT_L(0); PG8_MMA(1, 0, At, B0); PG8_BAR; PG8_SCHED;
            PG8_STAGE(PG8_SB(0, 1), b2 + hstep, voffB);
            PG8_WAIT_V(6); PG8_BAR; PG8_MMA(1, 1, At, B1); PG8_BAR;
            PG8_LDB(B0, 1, 0); PG8_SCHED; PG8_LDA(At, 1, 0); PG8_STAGE(PG8_SA(0, 1), a2 + hstep, voffA);
            PG8_WAIT_L(8); PG8_BAR; PG8_WAIT_L(0); PG8_MMA(0, 0, At, B0); PG8_BAR; PG8_SCHED;
            PG8_LDB(B1, 1, 1); PG8_STAGE(PG8_SB(1, 0), b3, voffB);
            PG8_BAR; PG8_WAIT_L(0); PG8_MMA(0, 1, At, B1); PG8_BAR;
            PG8_LDA(At, 1, 1); PG8_STAGE(PG8_SA(1, 0), a3, voffA);
            PG8_BAR; PG8_WAIT_L(0); PG8_MMA(1, 0, At, B0); PG8_BAR; PG8_SCHED;
            PG8_STAGE(PG8_SB(1, 1), b3 + hstep, voffB);
            PG8_WAIT_V(6); PG8_BAR; PG8_MMA(1, 1, At, B1); PG8_BAR;
        }
        epilogue(acc, cur, wr, wc, fr, fq, E);
        if (!has_next) break;
#pragma unroll
        for (int a = 0; a < 2; ++a)
#pragma unroll
            for (int b = 0; b < 2; ++b)
#pragma unroll
                for (int m = 0; m < 4; ++m)
#pragma unroll
                    for (int n = 0; n < 2; ++n) acc[a][b][m][n] = (f32x4){0.f, 0.f, 0.f, 0.f};
        cur = nxt; cA = nA; cB = nB; ++ui;
    }
    PG8_WAIT_V(0);
    if (wr == 0) PG8_BAR;
    PG8_BAR;
#undef PG8_SA
#undef PG8_SB
#undef PG8_STAGE
#undef PG8_LDA
#undef PG8_LDB
#undef PG8_MMA
#undef PG8_WAIT_V
#undef PG8_WAIT_L
#undef PG8_BAR
#undef PG8_SCHED
}
}

template <int DV, bool WIN>
DI void attn_unit(LAS unsigned char* lds, const bf16_t* __restrict__ P, bf16_t* __restrict__ MIX, int b, int hh, int qblk, bool ctxq, float lam, const float* __restrict__ sink, int wv_) {
    constexpr int KW = WIN ? 64 : 128, KP = KW * 2 + 16, VP = DV == 128 ? 320 : 192  , KCH = KW / 8, VCH = DV / 8, KN = 64 * KCH / NTHR, VN = 64 * VCH / NTHR, NDT = DV / 32;
    const int tid = otid(), lane = tid & 63, w = __builtin_amdgcn_readfirstlane(tid >> 6), l31 = lane & 31, h = lane >> 5;
    const int base_row = ctxq ? ML + b * LC : b * LQ, crow0 = ML + b * LC, lrow0 = b * LQ;
    int qrow0, qcol, kcol, koff, vcol, lt0 = 0, nlt = 0, qpos0 = 0; float m_run, l_run;
    if (!WIN) { const int rg = w & 3, st = w >> 2; qrow0 = base_row + qblk * 128 + rg * 32; qcol = hh * 128 + st * 64; kcol = 512 + hh * 128; koff = st * 64; vcol = 1024 + hh * 128;
        m_run = -1e30f; l_run = 0.f; if (!ctxq) { lt0 = 0; nlt = 128; } }
    else { const int g = w & 3, rg = w >> 2; qrow0 = base_row + qblk * 64 + rg * 32; qcol = 1536 + (hh * 4 + g) * 64; kcol = 2048 + hh * 64; koff = 0; vcol = 2176 + hh * 64;
        m_run = sink[hh * 4 + g] * LOG2E; l_run = h == 0 ? 1.f : 0.f; qpos0 = qblk * 64 + rg * 32;
        if (!ctxq) { lt0 = qblk - 2 < 0 ? 0 : qblk - 2; const int lt1 = qblk + 2 > 127 ? 127 : qblk + 2; nlt = lt1 - lt0 + 1; } }
    const int ntile = 4 + nlt;
    constexpr int IMGB = 64 * (KP + VP), NS = (IMGB + 8191) / 8192, IMG = NS * 8192;
    static_assert(3 * IMG <= LDS_BYTES - 16 && (NS == 5 || NS == 3), "attention LDS ring");
    unsigned goff[NS];
#pragma unroll
    for (int j = 0; j < NS; ++j) { const int o = (w + 8 * j) * 1024 + lane * 16; unsigned g = 0u;
        if (o < 64 * KP) { const int row = o / KP, cb = o % KP; if (cb < KW * 2) g = (unsigned)((row * EIN + kcol) * 2 + cb); }
        else if (o < IMGB) { const int o2 = o - 64 * KP, row = o2 / VP, cb = o2 % VP; if (cb < DV * 2) g = (unsigned)((row * EIN + vcol) * 2 + cb); }
        goff[j] = g; }
#define ATT_TROW(ti) ((ti) < 4 ? crow0 + 64 * (ti) : lrow0 + 64 * (lt0 + (ti) - 4))
#define ATT_DMA(ti, rb) do { const char* gb_ = (const char*)P + (size_t)ATT_TROW(ti) * (EIN * 2); \
        _Pragma("unroll") for (int j = 0; j < NS; ++j) __builtin_amdgcn_global_load_lds((const unsigned*)(gb_ + goff[j]), (LAS unsigned*)(lds + (rb) * IMG + (w + 8 * j) * 1024), 16, 0, 0); } while (0)
#define ATT_WAIT_TILE() do { if (NS == 5) asm volatile("s_waitcnt vmcnt(5)" ::: "memory"); else asm volatile("s_waitcnt vmcnt(3)" ::: "memory"); } while (0)
#define ATT_BAR() do { __builtin_amdgcn_s_barrier(); asm volatile("" ::: "memory"); } while (0)
    bf16x8 qf[4];
#pragma unroll
    for (int ks = 0; ks < 4; ++ks) qf[ks] = *(const bf16x8*)(P + (size_t)(qrow0 + l31) * EIN + qcol + 16 * ks + 8 * h);
    f32x16 o[NDT];
#pragma unroll
    for (int dt = 0; dt < NDT; ++dt) o[dt] = zero16();
    bf16x8 pf[4];
    bool first = !WIN;
    if (!WIN) m_run = 0.f;
#define ATT_PHASE1(ti) do { LAS unsigned char* Kb = lds + rb_ * IMG; \
        f32x16 s0, s1; _Pragma("unroll") for (int i = 0; i < 16; ++i) { s0[i] = -m_run; s1[i] = -m_run; } \
        _Pragma("unroll") for (int ks = 0; ks < 4; ++ks) { \
            const bf16x8 a0 = *(const LAS bf16x8*)(Kb + l31 * KP + (koff + 16 * ks + 8 * h) * 2); \
            const bf16x8 a1 = *(const LAS bf16x8*)(Kb + (32 + l31) * KP + (koff + 16 * ks + 8 * h) * 2); \
            s0 = MFMA32(a0, qf[ks], s0); s1 = MFMA32(a1, qf[ks], s1); } \
        if (WIN && (ti) >= 4) { const int kt0 = 64 * (lt0 + (ti) - 4), qpos = qpos0 + l31; \
            _Pragma("unroll") for (int i = 0; i < 16; ++i) { const int d0 = kt0 + crow(i, h) - qpos, d1 = d0 + 32; \
                if (d0 > 128 || d0 < -128) s0[i] = -1e30f; if (d1 > 128 || d1 < -128) s1[i] = -1e30f; } } \
        float mx = s0[0]; \
        _Pragma("unroll") for (int i = 1; i < 16; ++i) mx = fmaxf(mx, s0[i]); \
        _Pragma("unroll") for (int i = 0; i < 16; ++i) mx = fmaxf(mx, s1[i]); \
        mx = fmaxf(mx, shx(mx, 32, lane)); \
        if (first || __builtin_amdgcn_ballot_w64(mx > 8.0f) != 0ull) { \
            const float d = first ? mx : fmaxf(mx, 0.f), alpha = __builtin_amdgcn_exp2f(-d); m_run += d; l_run *= alpha; first = false; \
            _Pragma("unroll") for (int dt = 0; dt < NDT; ++dt) o[dt] *= alpha; \
            _Pragma("unroll") for (int i = 0; i < 16; ++i) { s0[i] -= d; s1[i] -= d; } } \
        float rs = 0.f; \
        _Pragma("unroll") for (int i = 0; i < 16; ++i) { s0[i] = __builtin_amdgcn_exp2f(s0[i]); s1[i] = __builtin_amdgcn_exp2f(s1[i]); rs += s0[i] + s1[i]; } \
        l_run += rs; \
        pf[0] = pack8(s0, 0); pf[1] = pack8(s0, 1); pf[2] = pack8(s1, 0); pf[3] = pack8(s1, 1); } while (0)
#define ATT_PHASE2(ti) do { LAS unsigned char* Vb = lds + rb_ * IMG + 64 * KP; \
        _Pragma("unroll") for (int kk = 0; kk < 4; ++kk) { const int kb = 16 * kk; \
            _Pragma("unroll") for (int dt = 0; dt < NDT; ++dt) { const bf16x8 vf = tr_frag(Vb, VP, kb + 4 * h, kb + 8 + 4 * h, 32 * dt + 16 * ((lane >> 4) & 1), lane); o[dt] = MFMA32(vf, pf[kk], o[dt]); } } } while (0)
    ATT_DMA(0, 0); ATT_DMA(1, 1);
    ATT_WAIT_TILE(); ATT_BAR();
    { int rb_ = 0;
      for (int ti = 0; ti < ntile; ++ti) {
          const int rb2 = rb_ >= 1 ? rb_ - 1 : 2;
          if (ti + 2 < ntile) ATT_DMA(ti + 2, rb2);
          ATT_PHASE1(ti); ATT_PHASE2(ti);
          if (ti + 2 < ntile) ATT_WAIT_TILE(); else asm volatile("s_waitcnt vmcnt(0)" ::: "memory");
          ATT_BAR();
          rb_ = rb_ == 2 ? 0 : rb_ + 1; } }
#undef ATT_PHASE1
#undef ATT_PHASE2
#undef ATT_TROW
#undef ATT_DMA
#undef ATT_WAIT_TILE
#undef ATT_BAR
    const float l_tot = l_run + shx(l_run, 32, lane), inv_l = 1.0f / l_tot;
    if (WIN) { const int g = w & 3; bf16_t* orow = MIX + (size_t)(qrow0 + l31) * DM + 512 + (hh * 4 + g) * 64;
#pragma unroll
        for (int dt = 0; dt < NDT; ++dt)
#pragma unroll
            for (int g4 = 0; g4 < 4; ++g4) { u32x2 wv; wv[0] = pk2(o[dt][4 * g4] * inv_l, o[dt][4 * g4 + 1] * inv_l); wv[1] = pk2(o[dt][4 * g4 + 2] * inv_l, o[dt][4 * g4 + 3] * inv_l);
                *(u32x2*)(orow + 32 * dt + 8 * g4 + 4 * h) = wv; }
    } else {
        const int rg = w & 3, st = w >> 2; LAS float* comb = (LAS float*)lds;
        if (st == 1) {
#pragma unroll
            for (int dt = 0; dt < NDT; ++dt)
#pragma unroll
                for (int i = 0; i < 16; ++i) comb[(rg * 128 + 32 * dt + crow(i, h)) * 32 + l31] = o[dt][i] * inv_l;
        }
        __syncthreads();
        if (st == 0) { float ss = 0.f;
#pragma unroll
            for (int dt = 0; dt < NDT; ++dt)
#pragma unroll
                for (int i = 0; i < 16; ++i) { const float d = o[dt][i] * inv_l - lam * comb[(rg * 128 + 32 * dt + crow(i, h)) * 32 + l31]; o[dt][i] = d; ss += d * d; }
            ss += shx(ss, 32, lane);
            const float sc = rsqrtf(ss * (1.0f / 128.0f) + 1e-6f) * 0.8f;
            bf16_t* orow = MIX + (size_t)(qrow0 + l31) * DM + hh * 128;
#pragma unroll
            for (int dt = 0; dt < NDT; ++dt)
#pragma unroll
                for (int g4 = 0; g4 < 4; ++g4) { u32x2 wv; wv[0] = pk2(o[dt][4 * g4] * sc, o[dt][4 * g4 + 1] * sc); wv[1] = pk2(o[dt][4 * g4 + 2] * sc, o[dt][4 * g4 + 3] * sc);
                    *(u32x2*)(orow + 32 * dt + 8 * g4 + 4 * h) = wv; }
        }
        __syncthreads();
    }
}
DI void attn_phase(LAS unsigned char* lds, const Params& p, int G, int bid, int wv_) {
    const bf16_t* P = (const bf16_t*)(p.ws + WS_P); bf16_t* MIX = (bf16_t*)(p.ws + WS_MIX);
    const float lam = ((const float*)(p.ws + WS_SCAL))[0]; const float* sink = ((const float*)(p.ws + WS_SMALL)) + SM_SINK;
    for (int u = bid; u < 2112; u += G) {
        if (u < 1024) { int qb = u & 63, bh = u >> 6;
            if (G == 256) { const int r = u >> 8, xcd = u & 7, j = (u & 255) >> 3; bh = 2 * xcd + (r >> 1); qb = (r & 1) * 32 + j; }
            attn_unit<128, false>(lds, P, MIX, bh >> 2, bh & 3, qb, false, lam, sink, wv_); }
        else if (u < 2048) { const int v = u - 1024, qb = v & 127, bk = v >> 7; attn_unit<64, true>(lds, P, MIX, bk >> 1, bk & 1, qb, false, lam, sink, wv_); }
        else if (u < 2080) { const int v = u - 2048, qb = v & 1, bh = v >> 1; attn_unit<128, false>(lds, P, MIX, bh >> 2, bh & 3, qb, true, lam, sink, wv_); }
        else { const int v = u - 2080, qb = v & 3, bk = v >> 2; attn_unit<64, true>(lds, P, MIX, bk >> 1, bk & 1, qb, true, lam, sink, wv_); }
    }
}

constexpr int GV_LR = 0, GV_V = 8192, GV_SCR = GV_V + 4 * 64 * 320, GV_END = GV_SCR + 8 * 4608;
static_assert(GV_END <= LDS_BYTES - 16, "GLA LDS map");
DI void gla_load_v(LAS unsigned char* lds, const bf16_t* __restrict__ P1, int row0, int tid) {
#pragma unroll
    for (int j = 0; j < 8; ++j) { const int id = tid + NTHR * j, r = id >> 6, c = id & 63;
        *(LAS u32x4*)(lds + GV_V + (c >> 4) * (64 * 320) + r * 320 + (c & 15) * 16) = *(const u32x4*)(P1 + (size_t)(row0 + r) * OINP + 512 + c * 8); }
}
DI void gla_pass1(LAS unsigned char* lds, const Params& p, int item, int wv_) {
    const int cid = item % NCH, b = item / NCH;
    const int tid = otid(), lane = tid & 63, w = __builtin_amdgcn_readfirstlane(tid >> 6), l31 = lane & 31, h = lane >> 5;
    const int dir = w >> 2, hd = w & 3, seq = (b * 2 + dir) * 4 + hd, d = lane;
    const bf16_t* P1 = (const bf16_t*)(p.ws + WS_P); const int row0 = chunk_row0(b, cid);
    const float* SM = (const float*)(p.ws + WS_SMALL);
    LAS unsigned char* QK = lds + GV_V;
    LAS bf16_t* SCR = (LAS bf16_t*)(lds + GV_SCR + w * 4608);
#pragma unroll
    for (int j = 0; j < 8; ++j) { const int id = tid + NTHR * j, r = id >> 6, c = id & 63; *(LAS u32x4*)(QK + r * 1040 + c * 16) = *(const u32x4*)(P1 + (size_t)(row0 + r) * OINP + c * 8); }
    bf16x8 la[2], gwb[2];
#pragma unroll
    for (int mt = 0; mt < 2; ++mt) la[mt] = *(const bf16x8*)(P1 + (size_t)(row0 + 32 * mt + l31) * OINP + 1536 + dir * 16 + 8 * h);
#pragma unroll
    for (int nt = 0; nt < 2; ++nt) { u32x4 pk;
#pragma unroll
        for (int j = 0; j < 4; ++j) pk[j] = pk2(SM[SM_GGW + (dir * 16 + 8 * h + 2 * j) * 256 + hd * 64 + 32 * nt + l31], SM[SM_GGW + (dir * 16 + 8 * h + 2 * j + 1) * 256 + hd * 64 + 32 * nt + l31]);
        gwb[nt] = __builtin_bit_cast(bf16x8, pk); }
    const float gb = SM[SM_GGB + dir * 256 + hd * 64 + d];
    __syncthreads();
    u32x4 vreg[8];
#pragma unroll
    for (int j = 0; j < 8; ++j) { const int id = tid + NTHR * j, r = id >> 6, c = id & 63; vreg[j] = *(const u32x4*)(P1 + (size_t)(row0 + r) * OINP + 512 + c * 8); }
    float g[64];
#pragma unroll
    for (int mt = 0; mt < 2; ++mt) { f32x16 c0 = MFMA32(la[mt], gwb[0], zero16()), c1 = MFMA32(la[mt], gwb[1], zero16());
#pragma unroll
        for (int r = 0; r < 16; ++r) { const auto sw = __builtin_amdgcn_permlane32_swap(__float_as_uint(c0[r]), __float_as_uint(c1[r]), false, false);
            const float x = __uint_as_float(sw[0]), y = __uint_as_float(sw[1]); const int t0 = 32 * mt + 8 * (r >> 2) + (r & 3);
            g[t0] = log_sigmoidf_(x + gb) * (1.0f / 16.0f); g[t0 + 4] = log_sigmoidf_(y + gb) * (1.0f / 16.0f); } }
    if (dir == 0) {
#pragma unroll
        for (int i = 1; i < 64; ++i) g[i] += g[i - 1];
    } else {
#pragma unroll
        for (int i = 62; i >= 0; --i) g[i] += g[i + 1];
    }
    const float blast = dir ? g[0] : g[63], eb = __expf(blast);
    ((float*)(p.ws + WS_GDEC))[((size_t)seq * NCH + cid) * 64 + d] = eb;
    bf16_t* QT = (bf16_t*)(p.ws + WS_QT); bf16_t* KT = (bf16_t*)(p.ws + WS_KT);
    u32x4 own[8];
#pragma unroll
    for (int th = 0; th < 2; ++th) {
#pragma unroll
        for (int ii = 0; ii < 32; ++ii) { const int i = 32 * th + ii; g[i] = __expf(g[i]);
            SCR[ii * 72 + d] = f2bf(bf2f(*(const LAS bf16_t*)(QK + i * 1040 + (hd * 64 + d) * 2)) * g[i]); }
#pragma unroll
        for (int j = 0; j < 4; ++j) { const int tk = (lane >> 3) + 8 * j, sg = lane & 7; const u32x4 v = *(const LAS u32x4*)(SCR + tk * 72 + sg * 8);
            *(u32x4*)(QT + ((size_t)(row0 + 32 * th + tk) * 2 + dir) * 256 + hd * 64 + sg * 8) = v; }
#pragma unroll
        for (int ii = 0; ii < 32; ii += 2) { const int i = 32 * th + ii;
            const float k0 = bf2f(*(const LAS bf16_t*)(QK + i * 1040 + (256 + hd * 64 + d) * 2)) * __builtin_amdgcn_rcpf(g[i]);
            const float k1 = bf2f(*(const LAS bf16_t*)(QK + (i + 1) * 1040 + (256 + hd * 64 + d) * 2)) * __builtin_amdgcn_rcpf(g[i + 1]);
            SCR[ii * 72 + d] = f2bf(k0); SCR[(ii + 1) * 72 + d] = f2bf(k1);
            own[i >> 3][(i & 7) >> 1] = pk2(k0 * eb, k1 * eb); }
#pragma unroll
        for (int j = 0; j < 4; ++j) { const int tk = (lane >> 3) + 8 * j, sg = lane & 7; const u32x4 v = *(const LAS u32x4*)(SCR + tk * 72 + sg * 8);
            *(u32x4*)(KT + ((size_t)(row0 + 32 * th + tk) * 2 + dir) * 256 + hd * 64 + sg * 8) = v; }
    }
    bf16x8 fr[4][2];
#pragma unroll
    for (int ks = 0; ks < 4; ++ks) { u32x4 a = own[2 * ks], bb = own[2 * ks + 1];
#pragma unroll
        for (int j = 0; j < 4; ++j) { const auto r = __builtin_amdgcn_permlane32_swap(a[j], bb[j], false, false); a[j] = r[0]; bb[j] = r[1]; }
        fr[ks][0] = __builtin_bit_cast(bf16x8, a); fr[ks][1] = __builtin_bit_cast(bf16x8, bb); }
    __syncthreads();
#pragma unroll
    for (int j = 0; j < 8; ++j) { const int id = tid + NTHR * j, r = id >> 6, c = id & 63; *(LAS u32x4*)(lds + GV_V + (c >> 4) * (64 * 320) + r * 320 + (c & 15) * 16) = vreg[j]; }
    __syncthreads();
    LAS unsigned char* Vt = lds + GV_V + hd * (64 * 320);
    bf16_t* St = (bf16_t*)(p.ws + WS_H) + ((size_t)seq * NCH + cid) * 8192;
#pragma unroll
    for (int et = 0; et < 4; ++et) { f32x16 a0 = zero16(), a1 = zero16();
#pragma unroll
        for (int ks = 0; ks < 4; ++ks) { const bf16x8 vf = tr_frag(Vt, 320, 16 * ks + 8 * h, 16 * ks + 8 * h + 4, 32 * et + 16 * ((lane >> 4) & 1), lane);
            a0 = MFMA32(vf, fr[ks][0], a0); a1 = MFMA32(vf, fr[ks][1], a1); }
#pragma unroll
        for (int r = 0; r < 16; ++r) { SCR[crow(r, h) * 72 + l31] = f2bf(a0[r]); SCR[crow(r, h) * 72 + 32 + l31] = f2bf(a1[r]); }
#pragma unroll
        for (int j = 0; j < 4; ++j) { const int er = (lane >> 3) + 8 * j, sg = lane & 7; const u32x4 v = *(const LAS u32x4*)(SCR + er * 72 + sg * 8);
            *(u32x4*)(St + (32 * et + er) * 64 + sg * 8) = v; } }
    __syncthreads();
}
DI int scan_cid(int dir, int sidx) { return dir == 0 ? sidx : (sidx < 4 ? 3 - sidx : 135 - sidx); }
DI void gla_scan(const Params& p, int item, int wv_) {
    const int seq = item >> 3, slab = item & 7, dir = (seq >> 2) & 1; const int el = slab * 1024 + otid() * 2, d = el & 63;
    unsigned* St = (unsigned*)((bf16_t*)(p.ws + WS_H) + (size_t)seq * NCH * 8192 + el); const float* dec = (const float*)(p.ws + WS_GDEC) + (size_t)seq * NCH * 64 + d;
    float r0 = 0.f, r1 = 0.f;
    for (int s0 = 0; s0 < NCH; s0 += 12) { unsigned v[12]; f32x2 dc[12];
#pragma unroll
        for (int j = 0; j < 12; ++j) { const int cid = scan_cid(dir, s0 + j); v[j] = St[(size_t)cid * 4096]; dc[j] = *(const f32x2*)(dec + cid * 64); }
#pragma unroll
        for (int j = 0; j < 12; ++j) { const int cid = scan_cid(dir, s0 + j); St[(size_t)cid * 4096] = pk2(r0, r1); r0 = dc[j][0] * r0 + bflo(v[j]); r1 = dc[j][1] * r1 + bfhi(v[j]); } }
}
DI void gla_pass3(LAS unsigned char* lds, const Params& p, int item, int wv_) {
    const int lc = item & 127, b = item >> 7, cid = lc + 4;
    const int tid = otid(), lane = tid & 63, w = __builtin_amdgcn_readfirstlane(tid >> 6), l31 = lane & 31, h = lane >> 5;
    const int hd = w >> 1, it = w & 1;
    const bf16_t* P1 = (const bf16_t*)(p.ws + WS_P); const int row0 = chunk_row0(b, cid);
    const bf16_t* QT = (const bf16_t*)(p.ws + WS_QT); const bf16_t* KT = (const bf16_t*)(p.ws + WS_KT);
    gla_load_v(lds, P1, row0, tid);
    __syncthreads();
    LAS unsigned char* Vt = lds + GV_V + hd * (64 * 320);
    f32x16 o[4];
#pragma unroll
    for (int et = 0; et < 4; ++et) o[et] = zero16();
    const int iq = 32 * it + l31;
    for (int dir = 0; dir < 2; ++dir) {
        const int seq = (b * 2 + dir) * 4 + hd;
        const bf16_t* St = (const bf16_t*)(p.ws + WS_H) + ((size_t)seq * NCH + cid) * 8192;
        bf16x8 qf[4], kf[2][4], sf[4][4];
#pragma unroll
        for (int ks = 0; ks < 4; ++ks) qf[ks] = *(const bf16x8*)(QT + ((size_t)(row0 + iq) * 2 + dir) * 256 + hd * 64 + 16 * ks + 8 * h);
#pragma unroll
        for (int jt = 0; jt < 2; ++jt)
#pragma unroll
            for (int ks = 0; ks < 4; ++ks) kf[jt][ks] = *(const bf16x8*)(KT + ((size_t)(row0 + 32 * jt + l31) * 2 + dir) * 256 + hd * 64 + 16 * ks + 8 * h);
#pragma unroll
        for (int ks = 0; ks < 4; ++ks)
#pragma unroll
            for (int et = 0; et < 4; ++et) sf[ks][et] = *(const bf16x8*)(St + (32 * et + l31) * 64 + 16 * ks + 8 * h);
        __builtin_amdgcn_sched_barrier(0);
#pragma unroll
        for (int jt = 0; jt < 2; ++jt) {
            if (dir == 0 ? (jt > it) : (jt < it)) continue;
            f32x16 at = zero16();
#pragma unroll
            for (int ks = 0; ks < 4; ++ks) at = MFMA32(kf[jt][ks], qf[ks], at);
#pragma unroll
            for (int r = 0; r < 16; ++r) { const int j = 32 * jt + crow(r, h); const bool ok = dir ? (j >= iq) : (j <= iq); at[r] = ok ? at[r] : 0.f; }
#pragma unroll
            for (int s2 = 0; s2 < 2; ++s2) { const bf16x8 pf = pack8(at, s2); const int kb = 32 * jt + 16 * s2;
#pragma unroll
                for (int et = 0; et < 4; ++et) { const bf16x8 vf = tr_frag(Vt, 320, kb + 4 * h, kb + 8 + 4 * h, 32 * et + 16 * ((lane >> 4) & 1), lane); o[et] = MFMA32(vf, pf, o[et]); } }
        }
#pragma unroll
        for (int ks = 0; ks < 4; ++ks)
#pragma unroll
            for (int et = 0; et < 4; ++et) o[et] = MFMA32(sf[ks][et], qf[ks], o[et]);
    }
    float ss = 0.f;
#pragma unroll
    for (int et = 0; et < 4; ++et)
#pragma unroll
        for (int r = 0; r < 16; ++r) ss += o[et][r] * o[et][r];
    ss += shx(ss, 32, lane);
    const float rstd = rsqrtf(ss * (1.0f / 128.0f) + 1e-6f); const float* gng = (const float*)(p.ws + WS_SMALL) + SM_GNG;
    const bf16_t* gp = P1 + (size_t)(row0 + iq) * OINP + 1024 + hd * 128; bf16_t* op = (bf16_t*)(p.ws + WS_MIX) + (size_t)(row0 + iq) * DM + hd * 128;
#pragma unroll
    for (int et = 0; et < 4; ++et)
#pragma unroll
        for (int g4 = 0; g4 < 4; ++g4) { const int e0 = 32 * et + 8 * g4 + 4 * h; const u32x2 gv = *(const u32x2*)(gp + e0); const f32x4 gn = *(const f32x4*)(gng + e0);
            u32x2 wv; wv[0] = pk2(o[et][4 * g4] * rstd * gn[0] * siluf_(bflo(gv[0])), o[et][4 * g4 + 1] * rstd * gn[1] * siluf_(bfhi(gv[0])));
            wv[1] = pk2(o[et][4 * g4 + 2] * rstd * gn[2] * siluf_(bflo(gv[1])), o[et][4 * g4 + 3] * rstd * gn[3] * siluf_(bfhi(gv[1])));
            *(u32x2*)(op + e0) = wv; }
    __syncthreads();
}

constexpr int LR_XR = 0, LR_XB = LR_XR + 128 * 65 * 4, LR_HS = LR_XB + 128 * 144, LR_END = LR_HS + 4 * 64 * 65 * 4;
static_assert(LR_END <= LDS_BYTES - 16 && (LR_XB % 16) == 0, "LRU LDS map");
template <int DIR, bool FINAL>
DI void lru_scan_regs(float (&a)[32], float (&u)[32], float h_in, int h, int lane, float& ptot, float& hend) {
    float PG[8], HG[8], PP[8], HP[8], carry[8];
#pragma unroll
    for (int gi = 0; gi < 8; ++gi) { float P = 1.f, H = 0.f;
#pragma unroll
        for (int s4 = 0; s4 < 4; ++s4) { const int r = (gi >> 2) * 16 + (gi & 3) * 4 + (DIR ? 3 - s4 : s4); H = a[r] * H + u[r]; P *= a[r]; }
        PG[gi] = P; HG[gi] = H; }
#pragma unroll
    for (int gi = 0; gi < 8; ++gi) { PP[gi] = shx(PG[gi], 32, lane); HP[gi] = shx(HG[gi], 32, lane); }
    float hc = h_in, pt = 1.f;
#pragma unroll
    for (int s = 0; s < 16; ++s) { const int G = DIR ? 15 - s : s, gi = G >> 1; const bool mine = ((G & 1) == h);
        const float P = mine ? PG[gi] : PP[gi], H = mine ? HG[gi] : HP[gi];
        if (DIR ? (G & 1) == 1 : (G & 1) == 0) carry[gi] = hc; else carry[gi] = mine ? hc : carry[gi];
        hc = P * hc + H; pt *= P; }
    ptot = pt; hend = hc;
    if (FINAL) {
#pragma unroll
        for (int gi = 0; gi < 8; ++gi) { float hr = carry[gi];
#pragma unroll
            for (int s4 = 0; s4 < 4; ++s4) { const int r = (gi >> 2) * 16 + (gi & 3) * 4 + (DIR ? 3 - s4 : s4); hr = a[r] * hr + u[r]; u[r] = hr; } }
    }
}
template <bool FINAL>
DI void lru_pass(LAS unsigned char* lds, const Params& p, int item, int wv_) {
    const int nbp = item & 3, bc = item >> 2, cid = bc % NCH, b = bc / NCH;
    const int tid = otid(), lane = tid & 63, w = __builtin_amdgcn_readfirstlane(tid >> 6), l31 = lane & 31, h = lane >> 5;
    const bf16_t* P1 = (const bf16_t*)(p.ws + WS_P); const int row0 = chunk_row0(b, cid);
    const int ts = cid < 4 ? cid * 64 : (cid - 4) * 64, seglen = cid < 4 ? LC : LQ, seg_row0 = row0 - ts;
    const float* SM = (const float*)(p.ws + WS_SMALL);
    LAS float* XR = (LAS float*)(lds + LR_XR); LAS bf16_t* XB = (LAS bf16_t*)(lds + LR_XB); LAS float* HS = (LAS float*)(lds + LR_HS);
    const int nbl = w >> 2, dir = (w >> 1) & 1, dh = w & 1, nb = nbp * 2 + nbl, d = 32 * dh + l31, ch = nb * 64 + d;
    const bf16_t* Wa = (const bf16_t*)(p.ws + WS_WGT) + (size_t)((dir * 2 + 0) * 8 + nb) * 4096 + d * 64; const bf16_t* Wx = (const bf16_t*)(p.ws + WS_WGT) + (size_t)((dir * 2 + 1) * 8 + nb) * 4096 + d * 64;
    bf16x8 wa[4], wx[4];
#pragma unroll
    for (int ks = 0; ks < 4; ++ks) { wa[ks] = *(const bf16x8*)(Wa + 16 * ks + 8 * h); wx[ks] = *(const bf16x8*)(Wx + 16 * ks + 8 * h); }
    const float ba = SM[SM_BA + dir * 512 + ch], bx = SM[SM_BX + dir * 512 + ch], lamv = SM[SM_LAM + dir * 512 + ch];
    float h_in = 0.f; const size_t cidx = ((size_t)(b * 2 + dir) * NCH + cid) * 512 + ch;
    if (FINAL) h_in = ((const float*)(p.ws + WS_LRUC))[cidx];
    u32x4 zg0 = {0u, 0u, 0u, 0u}, zg1 = zg0;
    if (FINAL) { const bf16_t* zp = P1 + (size_t)(row0 + (tid >> 3)) * OINP + 1568 + nbp * 128 + (tid & 7) * 16; zg0 = *(const u32x4*)zp; zg1 = *(const u32x4*)(zp + 8); }
    { const int i = tid >> 3, c0 = (tid & 7) * 16, ch0 = nbp * 128 + c0; float acc[16];
#pragma unroll
      for (int j = 0; j < 16; ++j) acc[j] = SM[SM_CB + ch0 + j];
      u32x4 zz[4][2];
#pragma unroll
      for (int tap = 0; tap < 4; ++tap) { const int t = ts + i + tap - 1, tc = t < 0 ? 0 : (t >= seglen ? seglen - 1 : t);
          const bf16_t* zp = P1 + (size_t)(seg_row0 + tc) * OINP + 2080 + ch0; zz[tap][0] = *(const u32x4*)zp; zz[tap][1] = *(const u32x4*)(zp + 8); }
#pragma unroll
      for (int tap = 0; tap < 4; ++tap) { const int t = ts + i + tap - 1; const float ok = (t >= 0 && t < seglen) ? 1.f : 0.f; const float* wt = SM + SM_CW + tap * 512 + ch0; const u32x4 z0 = zz[tap][0], z1 = zz[tap][1];
#pragma unroll
          for (int j = 0; j < 4; ++j) { acc[2 * j] += bflo(z0[j]) * (wt[2 * j] * ok); acc[2 * j + 1] += bfhi(z0[j]) * (wt[2 * j + 1] * ok); acc[8 + 2 * j] += bflo(z1[j]) * (wt[8 + 2 * j] * ok); acc[8 + 2 * j + 1] += bfhi(z1[j]) * (wt[8 + 2 * j + 1] * ok); } }
      const int rowi = (c0 >> 6) * 64 + i, cc = c0 & 63; u32x4 x0, x1;
#pragma unroll
      for (int j = 0; j < 16; ++j) XR[rowi * 65 + cc + j] = acc[j];
#pragma unroll
      for (int j = 0; j < 4; ++j) { x0[j] = pk2(acc[2 * j], acc[2 * j + 1]); x1[j] = pk2(acc[8 + 2 * j], acc[8 + 2 * j + 1]); }
      *(LAS u32x4*)(XB + rowi * 72 + cc) = x0; *(LAS u32x4*)(XB + rowi * 72 + cc + 8) = x1; }
    __syncthreads();
    float av[32], uv[32];
    { const float sp = log1p_small(__expf(-lamv)), cexp = -8.0f * LOG2E * sp;
#pragma unroll
      for (int mt = 0; mt < 2; ++mt) { f32x16 ca = zero16(), cx = zero16();
#pragma unroll
          for (int ks = 0; ks < 4; ++ks) { const bf16x8 af = *(const LAS bf16x8*)(XB + (nbl * 64 + 32 * mt + l31) * 72 + 16 * ks + 8 * h); ca = MFMA32(af, wa[ks], ca); cx = MFMA32(af, wx[ks], cx); }
#pragma unroll
          for (int r = 0; r < 16; ++r) { const int i = 32 * mt + crow(r, h);
              const float rr = __builtin_amdgcn_rcpf(1.0f + __builtin_amdgcn_exp2f(ca[r] + ba)), ii = __builtin_amdgcn_rcpf(1.0f + __builtin_amdgcn_exp2f(cx[r] + bx));
              const float aa = __builtin_amdgcn_exp2f(cexp * rr); av[mt * 16 + r] = aa; uv[mt * 16 + r] = __builtin_amdgcn_sqrtf(__builtin_fmaf(-aa, aa, 1.0f)) * (ii * XR[(nbl * 64 + i) * 65 + d]); } } }
    float ptot, hend;
    if (dir == 0) lru_scan_regs<0, FINAL>(av, uv, h_in, h, lane, ptot, hend); else lru_scan_regs<1, FINAL>(av, uv, h_in, h, lane, ptot, hend);
    if (!FINAL) { if (h == 0) { float* o = (float*)(p.ws + WS_LRUP) + cidx * 2; o[0] = ptot; o[1] = hend; } }
    else {
#pragma unroll
        for (int mt = 0; mt < 2; ++mt)
#pragma unroll
            for (int r = 0; r < 16; ++r) HS[((dir * 2 + nbl) * 64 + 32 * mt + crow(r, h)) * 65 + d] = uv[mt * 16 + r];
        __syncthreads();
        const int i = tid >> 3, c0 = (tid & 7) * 16, ch0 = nbp * 128 + c0, nl = c0 >> 6, cc = c0 & 63;
        const u32x4 z0 = zg0, z1 = zg1;
        u32x4 o0, o1;
#pragma unroll
        for (int j = 0; j < 4; ++j) { const LAS float* f0 = HS + ((0 * 2 + nl) * 64 + i) * 65 + cc; const LAS float* f1 = HS + ((1 * 2 + nl) * 64 + i) * 65 + cc;
            o0[j] = pk2((f0[2 * j] + f1[2 * j]) * gelu_tanh(bflo(z0[j])), (f0[2 * j + 1] + f1[2 * j + 1]) * gelu_tanh(bfhi(z0[j])));
            o1[j] = pk2((f0[8 + 2 * j] + f1[8 + 2 * j]) * gelu_tanh(bflo(z1[j])), (f0[8 + 2 * j + 1] + f1[8 + 2 * j + 1]) * gelu_tanh(bfhi(z1[j]))); }
        bf16_t* op = (bf16_t*)(p.ws + WS_MIX) + (size_t)(row0 + i) * DM + 512 + ch0; *(u32x4*)op = o0; *(u32x4*)(op + 8) = o1;
    }
    __syncthreads();
}
DI void lru_scan(const Params& p, int item, int wv_) {
    const int gi = item * NTHR + otid(), ch = gi & 511, bd = gi >> 9, dir = bd & 1;
    const float* ph = (const float*)(p.ws + WS_LRUP) + ((size_t)bd * NCH * 512 + ch) * 2; float* cr = (float*)(p.ws + WS_LRUC) + (size_t)bd * NCH * 512 + ch;
    float hh = 0.f;
    for (int s0 = 0; s0 < NCH; s0 += 12) { f32x2 v[12];
#pragma unroll
        for (int j = 0; j < 12; ++j) v[j] = *(const f32x2*)(ph + (size_t)scan_cid(dir, s0 + j) * 1024);
#pragma unroll
        for (int j = 0; j < 12; ++j) { cr[(size_t)scan_cid(dir, s0 + j) * 512] = hh; hh = v[j][0] * hh + v[j][1]; } }
}

#define XB_TMO      128
#define XB_XCNT(j)  (256  + 64 * (j))
#define XB_XSUB(j)  (1280 + 64 * (j))
#define XB_XGEN(j)  (2304 + 64 * (j))
#define XB_TOP      3328
#define XB_TOPGEN   3392
#define XCD_BAR_WORDS 3456
#define XB_SPIN_CAP (1u << 20)
DI unsigned xb_ld(unsigned* p)              { return __hip_atomic_load(p, __ATOMIC_RELAXED, __HIP_MEMORY_SCOPE_AGENT); }
DI unsigned xb_add(unsigned* p, unsigned v) { return __hip_atomic_fetch_add(p, v, __ATOMIC_RELAXED, __HIP_MEMORY_SCOPE_AGENT); }
DI unsigned xb_xcc_id() { return (unsigned)__builtin_amdgcn_s_getreg((3 << 11) | 20) & 0xFu; }
#define XB_SPIN(cond, bar) do { unsigned _sp = 0; while (cond) { __builtin_amdgcn_s_sleep(1); \
    if ((++_sp & 255u) == 0u) { if (xb_ld(&(bar)[XB_TMO])) break; if (_sp > XB_SPIN_CAP) { atomicAdd(&(bar)[XB_TMO], 1u); break; } } } } while (0)
struct XcdBarrier { unsigned* bar; unsigned x; volatile LAS unsigned* st; };
DI void xcd_barrier_complete(unsigned* bar, unsigned x, unsigned& nloc, unsigned& nx) {
    const unsigned G = gridDim.x * gridDim.y * gridDim.z;
    unsigned sum, cnt, mine, sp = 0u;
    for (;;) {
        sum = 0u; cnt = 0u; mine = 0u;
#pragma unroll
        for (unsigned j = 0; j < 16; ++j) { const unsigned c = xb_ld(&bar[XB_XCNT(j)]); sum += c; cnt += (c > 0u) ? 1u : 0u; mine = (j == x) ? c : mine; }
        if (sum == G) break;
        __builtin_amdgcn_s_sleep(1);
        if ((++sp & 255u) == 0u) { if (xb_ld(&bar[XB_TMO])) break; if (sp > XB_SPIN_CAP) { atomicAdd(&bar[XB_TMO], 1u); break; } }
    }
    nloc = mine > 0u ? mine : 1u; nx = cnt > 0u ? cnt : 1u;
}
DI void xcd_barrier(const XcdBarrier& b, int wv_) {
    asm volatile("s_waitcnt vmcnt(0)" ::: "memory");
    __syncthreads();
    if (otid() == 0) {
        unsigned* bar = b.bar;
        __builtin_amdgcn_s_waitcnt(0);
        unsigned nloc = b.st[0], nx = b.st[1];
        if (nloc == 0u) { xcd_barrier_complete(bar, b.x, nloc, nx); b.st[0] = nloc; b.st[1] = nx; }
        const unsigned old = xb_add(&bar[XB_XSUB(b.x)], 1u);
        const unsigned gen = old / nloc;
        if (old + 1u == (gen + 1u) * nloc) {
            __builtin_amdgcn_fence(__ATOMIC_RELEASE, "agent");
            asm volatile("s_waitcnt vmcnt(0)" ::: "memory");
            const unsigned og = xb_add(&bar[XB_TOP], 1u);
            const unsigned tg = og / nx;
            if (og + 1u == (tg + 1u) * nx) xb_add(&bar[XB_TOPGEN], 1u);
            else XB_SPIN(xb_ld(&bar[XB_TOPGEN]) == tg, bar);
            __builtin_amdgcn_fence(__ATOMIC_ACQUIRE, "agent");
            xb_add(&bar[XB_XGEN(b.x)], 1u);
            asm volatile("s_waitcnt vmcnt(0)" ::: "memory");
        } else {
            XB_SPIN(xb_ld(&bar[XB_XGEN(b.x)]) == gen, bar);
            __builtin_amdgcn_fence(__ATOMIC_ACQUIRE, "agent");
            asm volatile("s_waitcnt vmcnt(0)" ::: "memory");
        }
    }
    __syncthreads();
}

__global__ void __launch_bounds__(NTHR) fwd_megakernel(const Params p) {
    extern __shared__ __attribute__((aligned(16))) unsigned char lds_raw[];
    cg::grid_group grid = cg::this_grid();
    constexpr int XB_LDS_OFF = LDS_BYTES - 16;
    const int wv_ = __builtin_amdgcn_readfirstlane((int)threadIdx.x >> 6);
    { const int t0 = otid(); if (blockIdx.x == 0) { unsigned* bw = (unsigned*)(p.ws + WS_BAR); for (int i = t0; i < XCD_BAR_WORDS; i += NTHR) bw[i] = 0u; }
      if (t0 < 4) ((LAS unsigned*)((LAS unsigned char*)lds_raw + XB_LDS_OFF))[t0] = 0u; }
    __syncthreads();
    { int oz = 0; asm volatile("" : "+s"(oz)); Params q = p; q.ws = p.ws + oz; phase0((LAS unsigned char*)lds_raw + oz, q, (int)gridDim.x + oz, (int)blockIdx.x + oz, wv_); }
    grid.sync();
    if (otid() == 0) (void)xb_add(&((unsigned*)(p.ws + WS_BAR))[XB_XCNT(xb_xcc_id())], 1u);
#ifndef PROBE_MASK
#define PROBE_MASK 0u
#endif
    for (int ph = 0; ph < 17; ++ph) {
      for (int rep = 0; rep <= (int)((PROBE_MASK >> ph) & 1u); ++rep) {
        int oz = 0; asm volatile("" : "+s"(oz));
        Params q = p; q.ws = p.ws + oz; q.out = p.out + oz;
        const Params& p = q;
        LAS unsigned char* lds = (LAS unsigned char*)lds_raw + oz;
        const int G = (int)gridDim.x + oz, bid = (int)blockIdx.x + oz;
        unsigned char* ws = p.ws;
        bf16_t* H = (bf16_t*)(ws + WS_H); bf16_t* PB = (bf16_t*)(ws + WS_P); bf16_t* MIX = (bf16_t*)(ws + WS_MIX);
        bf16_t* XB = (bf16_t*)(ws + WS_X);
        const float* MOD = (const float*)(ws + WS_MOD); const float* ROPE = (const float*)(ws + WS_ROPE);
        const int li = ph < 7 ? 0 : 1;
        const float* mod = MOD + (size_t)li * 5 * 6144; const float* SMALLP = (const float*)(ws + WS_SMALL);
        if (ph == 0) norm_phase(G, bid, MT, p.in[0], p.in[2], XB, SMALLP + SM_NORMG, mod, 0, 1024, H, wv_);
        else if (ph == 4) norm_phase_x<0>(G, bid, MT, XB, SMALLP + SM_NORMG + 1024, mod, 3072, 4096, H, nullptr, wv_);
        else if (ph == 7) norm_phase_x<0>(G, bid, MT, XB, SMALLP + SM_NORMG + 2048, mod, 0, 1024, H, nullptr, wv_);
        else if (ph == 13) norm_phase_x<0>(G, bid, ML, XB, SMALLP + SM_NORMG + 3072, mod, 3072, 4096, H, nullptr, wv_);
        else if (ph == 1 || ph == 3 || ph == 5 || ph == 6 || ph == 8 || ph == 12 || ph == 14 || ph == 15) {
            pg8::Gemm g; pg8::Epi E; E.xb = XB; E.rope = ROPE; E.gate = mod; E.O = PB;
            if (ph == 1) { g = pg8::Gemm{H, (const bf16_t*)(ws + WS_W_EIN), MT, EIN, DM}; E.mode = pg8::EPI_EVEN_IN; }
            else if (ph == 3) { g = pg8::Gemm{MIX, (const bf16_t*)(ws + WS_W_EOUT), MT, DM, DM}; E.mode = pg8::EPI_RESID; E.gate = mod + 2048; }
            else if (ph == 5) { g = pg8::Gemm{H, (const bf16_t*)(ws + WS_W_FIN), MT, 5632, DM}; E.mode = pg8::EPI_SWIGLU; }
            else if (ph == 6) { g = pg8::Gemm{PB, (const bf16_t*)(ws + WS_W_FOUT), MT, DM, DFF}; E.mode = pg8::EPI_RESID; E.gate = mod + 5120; }
            else if (ph == 8) { g = pg8::Gemm{H, (const bf16_t*)(ws + WS_W_OIN), MT, OINP, DM}; E.mode = pg8::EPI_ODD_IN; }
            else if (ph == 12) { g = pg8::Gemm{MIX, (const bf16_t*)(ws + WS_W_OOUT), ML, DM, DM}; E.mode = pg8::EPI_RESID; E.gate = mod + 2048; }
            else if (ph == 14) { g = pg8::Gemm{H, (const bf16_t*)(ws + WS_W_FIN) + (size_t)5632 * 1024, ML, 5632, DM}; E.mode = pg8::EPI_SWIGLU; }
            else { g = pg8::Gemm{PB, (const bf16_t*)(ws + WS_W_FOUT) + (size_t)1024 * DFF, ML, DM, DFF}; E.mode = pg8::EPI_RESID; E.gate = mod + 5120; }
            pg8::StaticOrder S; S.init(g.M, g.N, G, bid);
            pg8::gemm_phase(lds, g, S, E, wv_);
            if (ph == 1 || ph == 3 || ph == 6) {
                const int ntile = (g.M / 256) * (g.N / 256), full = ntile % G;
                if (full != 0 && bid >= full) prep_slack(lds, ws, ph, bid - full, G - full, wv_); }
        }
        else if (ph == 2) attn_phase(lds, p, G, bid, wv_);
        else if (ph == 9) { for (int it = bid; it < 528 + 2112; it += G) { if (it < 528) gla_pass1(lds, p, it, wv_); else { lru_pass<false>(lds, p, it - 528, wv_);
#ifdef PROBE_LRU2
 lru_pass<false>(lds, p, it - 528, wv_);
#endif
 } } }
        else if (ph == 10) { for (int it = bid; it < 264; it += G) { if (it < 256) gla_scan(p, it, wv_); else lru_scan(p, it - 256, wv_); } }
        else if (ph == 11) { for (int it = bid; it < 512 + 2048; it += G) { if (it < 512) gla_pass3(lds, p, it, wv_);
                else { const int j = it - 512, nbp = j & 3, bc = j >> 2, lc = bc & 127, b = bc >> 7; lru_pass<true>(lds, p, ((b * NCH) + lc + 4) * 4 + nbp, wv_);
#ifdef PROBE_LRU2
 lru_pass<true>(lds, p, ((b * NCH) + lc + 4) * 4 + nbp, wv_);
#endif
 } } }
        else if (ph == 16) norm_phase_x<1>(G, bid, ML, XB, SMALLP + SM_FG, nullptr, 0, 0, nullptr, p.out, wv_);
        if (ph < 16) { XcdBarrier xb; xb.bar = (unsigned*)(ws + WS_BAR); xb.x = xb_xcc_id(); xb.st = (volatile LAS unsigned*)(lds + XB_LDS_OFF); xcd_barrier(xb, wv_); }
      }
    }
}

extern "C" void kernel_launch(void* const* d_in, const int* in_sizes, int n_in, void* d_out, int out_size, void* d_ws, size_t ws_size, hipStream_t stream) {
    static int grid_blocks = 0;
    if (grid_blocks == 0) {
        if (n_in != 26 || ws_size < WS_END) { fprintf(stderr, "kernel_launch: unexpected inputs (n_in %d, ws %zu, need %zu)\n", n_in, ws_size, (size_t)WS_END); grid_blocks = -1; return; }
        int dev = 0, cus = 0, per_cu = 0;
        hipGetDevice(&dev);
        hipDeviceGetAttribute(&cus, hipDeviceAttributeMultiprocessorCount, dev);
        if (hipFuncSetAttribute((const void*)fwd_megakernel, hipFuncAttributeMaxDynamicSharedMemorySize, LDS_BYTES) != hipSuccess) fprintf(stderr, "kernel_launch: hipFuncSetAttribute failed\n");
        hipOccupancyMaxActiveBlocksPerMultiprocessor(&per_cu, (const void*)fwd_megakernel, NTHR, LDS_BYTES);
        if (per_cu < 1) { fprintf(stderr, "kernel_launch: occupancy query says %d blocks per CU\n", per_cu); per_cu = 1; }
        (void)hipGetLastError();
        grid_blocks = cus;
    }
    if (grid_blocks < 0) return;
    Params p{};
    for (int i = 0; i < 26; ++i) p.in[i] = (const float*)d_in[i];
    p.out = (float*)d_out; p.ws = (unsigned char*)d_ws;
    void* args[] = {&p};
    hipError_t e = hipLaunchCooperativeKernel((const void*)fwd_megakernel, dim3(grid_blocks), dim3(NTHR), args, LDS_BYTES, stream);
    if (e != hipSuccess) fprintf(stderr, "cooperative launch failed: %s (grid %d)\n", hipGetErrorString(e), grid_blocks);
}
```
